# Optimizing an MI355X kernel written in HIP

```python
import math
import jax, jax.numpy as jnp
from jax import lax
import numpy as np

D_MODEL = 1024
BATCH = 4
SEQ = 4096
DEPTH = 1
DEC_BATCH = 128
DEC_SEQ = 8
PAST_LEN = 8192
PAGE_SIZE = 128

HEAD_DIM = 64
A_HEADS = 8
B_HEADS = 8
B_KV_HEADS = 2
B_GROUP = B_HEADS // B_KV_HEADS
A_PATTERNS = ((128, 1), (512, 4), (2048, 16))
A_WINDOW_MAX = 2048
B_WINDOW = 128
MIX_WIDTH = (A_HEADS + B_HEADS) * HEAD_DIM
QKV_COLS = 3 * A_HEADS * HEAD_DIM + (B_HEADS + 2 * B_KV_HEADS) * HEAD_DIM
SPLITS = [A_HEADS * HEAD_DIM, 2 * A_HEADS * HEAD_DIM, 3 * A_HEADS * HEAD_DIM,
          3 * A_HEADS * HEAD_DIM + B_HEADS * HEAD_DIM,
          3 * A_HEADS * HEAD_DIM + (B_HEADS + B_KV_HEADS) * HEAD_DIM]
Q_BLOCK = 128
PEER_HEADS = 8
PEER_NKEYS = 128
PEER_EXPERTS = PEER_NKEYS * PEER_NKEYS
PEER_QDIM = 256
PEER_HALF = PEER_QDIM // 2
PEER_TOPK = 16
PEER_BLOCK = 256
NORM_EPS = 1e-6
NEG = -1e30
SCALE = HEAD_DIM ** -0.5

kernel_name = 'hybrid_dilated_swa_peer_step'


def rms_norm(x, g):
    xf = x.astype(jnp.float32)
    y = xf * lax.rsqrt(jnp.mean(xf * xf, axis=-1, keepdims=True) + NORM_EPS)
    return (y * g.astype(jnp.float32)).astype(x.dtype)


def alibi_slopes(n):
    return 2.0 ** (-8.0 * jnp.arange(1, n + 1, dtype=jnp.float32) / n)


def attn_inputs(x, norm_g, w_in, g_qa, g_ka, g_qb, g_kb):
    B, L, _ = x.shape
    xn = rms_norm(x, norm_g)
    h = jnp.einsum('bld,dc->blc', xn, w_in)
    qa, ka, va, qb, kb, vb = jnp.split(h, SPLITS, axis=-1)
    qa = rms_norm(qa.reshape(B, L, A_HEADS, HEAD_DIM), g_qa)
    ka = rms_norm(ka.reshape(B, L, A_HEADS, HEAD_DIM), g_ka)
    va = va.reshape(B, L, A_HEADS, HEAD_DIM)
    qb = rms_norm(qb.reshape(B, L, B_KV_HEADS, B_GROUP, HEAD_DIM), g_qb)
    kb = rms_norm(kb.reshape(B, L, B_KV_HEADS, HEAD_DIM), g_kb)
    vb = vb.reshape(B, L, B_KV_HEADS, HEAD_DIM)
    return qa, ka, va, qb, kb, vb


def dilated_block(qb, qidx, k, v, slopes):
    ms, dens, nums = [], [], []
    for (w, d) in A_PATTERNS:
        n = w // d + 1
        dist = jnp.arange(n) * d
        kidx = qidx[:, None] - dist[None, :]
        valid = kidx >= 0
        kidx = jnp.maximum(kidx, 0)
        kg = jnp.take(k, kidx, axis=1)
        vg = jnp.take(v, kidx, axis=1)
        s = jnp.einsum('bqhd,bqnhd->bqhn', qb, kg).astype(jnp.float32) * SCALE
        s = s - slopes[:, None] * dist[None, :].astype(jnp.float32)
        s = jnp.where(valid[None, :, None, :], s, NEG)
        m = s.max(axis=-1)
        p = jnp.exp(s - m[..., None])
        ms.append(m)
        dens.append(p.sum(axis=-1))
        nums.append(jnp.einsum('bqhn,bqnhd->bqhd', p, vg.astype(jnp.float32)))
    ms = jnp.stack(ms)
    wts = jnp.exp(ms - ms.max(axis=0))
    den = (jnp.stack(dens) * wts).sum(axis=0)
    num = (jnp.stack(nums) * wts[..., None]).sum(axis=0)
    return (num / den[..., None]).astype(qb.dtype)


def dilated_attention(q, k, v, q_start, slopes):
    B, Lq, H, Dh = q.shape
    if Lq > Q_BLOCK and Lq % Q_BLOCK == 0:
        nb = Lq // Q_BLOCK
        qblocks = q.reshape(B, nb, Q_BLOCK, H, Dh).transpose(1, 0, 2, 3, 4)
        starts = q_start + jnp.arange(nb) * Q_BLOCK

        def body(args):
            qblk, s0 = args
            return dilated_block(qblk, s0 + jnp.arange(Q_BLOCK), k, v, slopes)

        out = lax.map(body, (qblocks, starts))
        return out.transpose(1, 0, 2, 3, 4).reshape(B, Lq, H, Dh)
    return dilated_block(q, q_start + jnp.arange(Lq), k, v, slopes)


def sink_attend(q, k, v, dist, valid, slopes, sinks):
    s = jnp.einsum('...qkgd,...nkd->...kgqn', q, k).astype(jnp.float32) * SCALE
    s = s - slopes[:, :, None, None] * dist.astype(jnp.float32)
    s = jnp.where(valid, s, NEG)
    sink = sinks.astype(jnp.float32)[:, :, None]
    m = jnp.maximum(s.max(axis=-1), sink)
    p = jnp.exp(s - m[..., None])
    den = p.sum(axis=-1) + jnp.exp(sink - m)
    o = jnp.einsum('...kgqn,...nkd->...qkgd', p, v.astype(jnp.float32))
    return (o / jnp.moveaxis(den, -1, -3)[..., None]).astype(q.dtype)


def swa_prompt(q, k, v, slopes, sinks):
    B, L, KV, G, Dh = q.shape
    blk = B_WINDOW
    nb = L // blk
    q6 = q.reshape(B, nb, blk, KV, G, Dh)
    kb = k.reshape(B, nb, blk, KV, Dh)
    vb = v.reshape(B, nb, blk, KV, Dh)
    pad = ((0, 0), (1, 0), (0, 0), (0, 0), (0, 0))
    kcat = jnp.concatenate([jnp.pad(kb, pad)[:, :-1], kb], axis=2)
    vcat = jnp.concatenate([jnp.pad(vb, pad)[:, :-1], vb], axis=2)
    dist = jnp.arange(blk)[:, None] + blk - jnp.arange(2 * blk)[None, :]
    band = (dist >= 0) & (dist <= B_WINDOW)
    exists = (jnp.arange(nb)[:, None, None] > 0) | (jnp.arange(2 * blk)[None, None, :] >= blk)
    valid = (band[None] & exists)[:, None, None]
    o = sink_attend(q6, kcat, vcat, dist, valid, slopes, sinks)
    return o.reshape(B, L, KV, G, Dh)


def swa_buffer(q, k_all, v_all, q_start, slopes, sinks):
    Lq = q.shape[1]
    Lk = k_all.shape[1]
    dist = (q_start + jnp.arange(Lq))[:, None] - jnp.arange(Lk)[None, :]
    valid = (dist >= 0) & (dist <= B_WINDOW)
    return sink_attend(q, k_all, v_all, dist, valid, slopes, sinks)


def peer_ffn(xn, w_pq, peer_keys, u_tab, v_tab):
    B, L, D = xn.shape
    xt = xn.reshape(-1, D)
    T = xt.shape[0]
    xt = jnp.pad(xt, ((0, (-T) % PEER_BLOCK), (0, 0)))
    xb = xt.reshape(-1, PEER_BLOCK, D)

    def block(xblk):
        q = (xblk @ w_pq).reshape(PEER_BLOCK, PEER_HEADS, 2, PEER_HALF)
        s = jnp.einsum('thpc,hpnc->thpn', q, peer_keys).astype(jnp.float32)
        sv, si = lax.top_k(s, PEER_TOPK)
        cand = sv[:, :, 0, :, None] + sv[:, :, 1, None, :]
        cidx = si[:, :, 0, :, None] * PEER_NKEYS + si[:, :, 1, None, :]
        cand = cand.reshape(PEER_BLOCK, PEER_HEADS, PEER_TOPK * PEER_TOPK)
        cidx = cidx.reshape(PEER_BLOCK, PEER_HEADS, PEER_TOPK * PEER_TOPK)
        fv, fi = lax.top_k(cand, PEER_TOPK)
        eidx = jnp.take_along_axis(cidx, fi, axis=-1)
        g = jax.nn.softmax(fv, axis=-1)
        u = u_tab[eidx]
        a = jax.nn.gelu(jnp.einsum('td,thkd->thk', xblk, u).astype(jnp.float32), approximate=False)
        coef = (g * a).astype(xblk.dtype)
        return jnp.einsum('thk,thkd->td', coef, v_tab[eidx])

    out = lax.map(block, xb).reshape(-1, D)[:T]
    return out.reshape(B, L, D)


def mix_out(oa, ob, w_o):
    B, L = oa.shape[:2]
    cat = jnp.concatenate([oa.reshape(B, L, -1), ob.reshape(B, L, -1)], axis=-1)
    return jnp.einsum('blc,cd->bld', cat, w_o)


def setup_inputs(seed: int = 0) -> dict:
    key = jax.random.key(seed)
    ks = jax.random.split(key, 20)
    la = min(A_WINDOW_MAX, PAST_LEN)
    lb = min(B_WINDOW, PAST_LEN)
    f32 = jnp.float32
    nrm = lambda k, shape: jax.random.normal(k, shape, f32)
    return {
        'x_prompt': nrm(ks[0], (BATCH, SEQ, D_MODEL)),
        'x_sample': nrm(ks[1], (DEC_BATCH, DEC_SEQ, D_MODEL)),
        'cache_a_k': nrm(ks[2], (DEPTH, DEC_BATCH, la, A_HEADS, HEAD_DIM)),
        'cache_a_v': nrm(ks[3], (DEPTH, DEC_BATCH, la, A_HEADS, HEAD_DIM)),
        'cache_b_k': nrm(ks[4], (DEPTH, DEC_BATCH, lb, B_KV_HEADS, HEAD_DIM)),
        'cache_b_v': nrm(ks[5], (DEPTH, DEC_BATCH, lb, B_KV_HEADS, HEAD_DIM)),
        'norm_attn': 1.0 + 0.02 * nrm(ks[6], (DEPTH, D_MODEL)),
        'w_in': nrm(ks[7], (DEPTH, D_MODEL, QKV_COLS)) * D_MODEL ** -0.5,
        'g_qa': 1.0 + 0.02 * nrm(ks[8], (DEPTH, HEAD_DIM)),
        'g_ka': 1.0 + 0.02 * nrm(ks[9], (DEPTH, HEAD_DIM)),
        'g_qb': 1.0 + 0.02 * nrm(ks[10], (DEPTH, HEAD_DIM)),
        'g_kb': 1.0 + 0.02 * nrm(ks[11], (DEPTH, HEAD_DIM)),
        'sinks': 0.5 * nrm(ks[12], (DEPTH, B_HEADS)),
        'w_o': nrm(ks[13], (DEPTH, MIX_WIDTH, D_MODEL)) * MIX_WIDTH ** -0.5,
        'norm_ffn': 1.0 + 0.02 * nrm(ks[14], (DEPTH, D_MODEL)),
        'peer_wq': nrm(ks[15], (DEPTH, D_MODEL, PEER_HEADS * PEER_QDIM)) * D_MODEL ** -0.5,
        'peer_keys': nrm(ks[16], (DEPTH, PEER_HEADS, 2, PEER_NKEYS, PEER_HALF)) * PEER_HALF ** -0.5,
        'peer_u': nrm(ks[17], (DEPTH, PEER_EXPERTS, D_MODEL)) * D_MODEL ** -0.5,
        'peer_v': nrm(ks[18], (DEPTH, PEER_EXPERTS, D_MODEL)) * (PEER_HEADS * PEER_TOPK) ** -0.5,
    }


def reference(x_prompt, x_sample, cache_a_k, cache_a_v, cache_b_k, cache_b_v,
              norm_attn, w_in, g_qa, g_ka, g_qb, g_kb, sinks, w_o, norm_ffn,
              peer_wq, peer_keys, peer_u, peer_v):
    slopes_a = alibi_slopes(A_HEADS)
    slopes_b = alibi_slopes(B_HEADS).reshape(B_KV_HEADS, B_GROUP)
    la = cache_a_k.shape[2]
    lb = cache_b_k.shape[2]
    xp, xs = x_prompt, x_sample
    pak, pav, pbk, pbv, sak, sav, sbk, sbv = [], [], [], [], [], [], [], []
    for l in range(DEPTH):
        sink_l = sinks[l].reshape(B_KV_HEADS, B_GROUP)
        qa, ka, va, qb, kb, vb = attn_inputs(xp, norm_attn[l], w_in[l], g_qa[l], g_ka[l], g_qb[l], g_kb[l])
        oa = dilated_attention(qa, ka, va, 0, slopes_a)
        ob = swa_prompt(qb, kb, vb, slopes_b, sink_l)
        h = xp + mix_out(oa, ob, w_o[l])
        xp = h + peer_ffn(rms_norm(h, norm_ffn[l]), peer_wq[l], peer_keys[l], peer_u[l], peer_v[l])
        L = ka.shape[1]
        pak.append(ka[:, L - min(A_WINDOW_MAX, L):])
        pav.append(va[:, L - min(A_WINDOW_MAX, L):])
        pbk.append(kb[:, L - min(B_WINDOW, L):])
        pbv.append(vb[:, L - min(B_WINDOW, L):])
        qa, ka, va, qb, kb, vb = attn_inputs(xs, norm_attn[l], w_in[l], g_qa[l], g_ka[l], g_qb[l], g_kb[l])
        ka_all = jnp.concatenate([cache_a_k[l].astype(ka.dtype), ka], axis=1)
        va_all = jnp.concatenate([cache_a_v[l].astype(va.dtype), va], axis=1)
        kb_all = jnp.concatenate([cache_b_k[l].astype(kb.dtype), kb], axis=1)
        vb_all = jnp.concatenate([cache_b_v[l].astype(vb.dtype), vb], axis=1)
        oa = dilated_attention(qa, ka_all, va_all, la, slopes_a)
        ob = swa_buffer(qb, kb_all, vb_all, lb, slopes_b, sink_l)
        h = xs + mix_out(oa, ob, w_o[l])
        xs = h + peer_ffn(rms_norm(h, norm_ffn[l]), peer_wq[l], peer_keys[l], peer_u[l], peer_v[l])
        sak.append(ka_all[:, ka_all.shape[1] - la:])
        sav.append(va_all[:, va_all.shape[1] - la:])
        sbk.append(kb_all[:, kb_all.shape[1] - lb:])
        sbv.append(vb_all[:, vb_all.shape[1] - lb:])
    return (xp, xs, jnp.stack(pak), jnp.stack(pav), jnp.stack(pbk), jnp.stack(pbv),
            jnp.stack(sak), jnp.stack(sav), jnp.stack(sbk), jnp.stack(sbv))
```

```cpp
#include <hip/hip_runtime.h>
#include <cstdio>
#include <cstdint>

#ifndef PEER_SCALE
#define PEER_SCALE 1.0f
#endif
#ifndef SB
#define SB 4
#endif
#ifndef CONV_IN_P1
#define CONV_IN_P1 1
#endif
#ifndef N_LAUNCHES
#define N_LAUNCHES 1
#endif

namespace pg8 {
#define PG8_LAS __attribute__((address_space(3)))
typedef unsigned short bf16_t;
typedef short bf16x8 __attribute__((ext_vector_type(8)));
typedef float f32x4 __attribute__((ext_vector_type(4)));
typedef unsigned u32x4 __attribute__((ext_vector_type(4)));
constexpr int BM = 256, BK = 64, HALF = 128, HTB = HALF * BK * 2  , STAGE_BYTES = 8 * HTB, NXCD = 8, WGM = 8;

__host__ __device__ __forceinline__ int lds_byte(int r, int c) { const int st = (r >> 4) * 2 + (c >> 5), rr = r & 15, cc = c & 31, ob = rr * 64 + cc * 2; return st * 1024 + (ob ^ (((ob >> 9) & 1) << 5)); }
__host__ __device__ __forceinline__ void stage_rc(int b, int& R, int& C) { const int st = b / 1024, sb = b % 1024, swz = sb ^ (((sb >> 9) & 1) << 5); R = (st >> 1) * 16 + swz / 64; C = (st & 1) * 32 + (swz % 64) / 2; }
__host__ __device__ __forceinline__ int perm32(int rho) { const int n = rho >> 4, i = rho & 15; return 8 * (i >> 2) + 4 * n + (i & 3); }

struct Unit { int pm, pn; };
struct Gemm { const bf16_t* A; const bf16_t* Bt; int M, N, K; };

struct StaticOrder {
    int nM, nN, nwg, G, c;
    __host__ __device__ void init(int M, int N, int G_, int c_) { nM = M / BM; nN = N / BM; nwg = nM * nN; G = G_; c = c_; }
    __host__ __device__ bool next(int i, Unit& u) const {
        const long L = (long)i * G + c; if (L >= nwg) return false;
        int wgid = (int)L; { const int q = nwg / NXCD, r = nwg % NXCD, xcd = wgid % NXCD, off = wgid / NXCD; wgid = (xcd < r ? xcd * (q + 1) : r * (q + 1) + (xcd - r) * q) + off; }
        const int nig = WGM * nN, gid = wgid / nig, fm = gid * WGM, gsz = (nM - fm) < WGM ? (nM - fm) : WGM;
        u.pm = fm + ((wgid % nig) % gsz); u.pn = (wgid % nig) / gsz; return true;
    }

    __device__ __forceinline__ void a_ready(const Unit&) const {}
    __device__ __forceinline__ void done(const Unit&) const {}
};
__device__ __forceinline__ unsigned cvt_pk_bf16(float lo, float hi) { unsigned r; asm volatile("v_cvt_pk_bf16_f32 %0, %1, %2" : "=v"(r) : "v"(lo), "v"(hi)); return r; }
template <class Epi, class Sched, bool ALIGN_EPI = false, bool SP2 = false>
__device__ __forceinline__ void gemm_phase(PG8_LAS unsigned char* lds, const Gemm g, const Sched& S, const Epi& E) {
    const int tid = threadIdx.x, wid = __builtin_amdgcn_readfirstlane(tid >> 6), lane = tid & 63, wr = wid >> 2, wc = wid & 3, fr = lane & 15, fq = lane >> 4;
    const int K = g.K, nt = K / BK;
    unsigned voffA[2], voffB[2];
#pragma unroll
    for (int i = 0; i < 2; ++i) { int R, C; stage_rc(tid * 16 + i * 8192, R, C); const int Rb = Epi::PERM ? ((R & ~31) + perm32(R & 31)) : R;
        voffA[i] = (unsigned)(R * K + C) * 2u; voffB[i] = (unsigned)(Rb * K + C) * 2u; }
    const size_t kstep = (size_t)(BK * 2);
    const size_t hstep = (size_t)HALF * K * 2;
    const size_t tstep = 2 * hstep;
    const unsigned ldsw = (unsigned)wid * 1024u;
    const int aoff = lds_byte(wr * 64 + fr, fq * 8), boff = lds_byte(wc * 32 + fr, fq * 8);
#define PG8_SA(b, h) (((b) * 2 + (h)) * HTB)
#define PG8_SB(b, h) ((4 + (b) * 2 + (h)) * HTB)
#define PG8_STAGE(bufoff, gbase, voff) do { _Pragma("unroll") for (int _i = 0; _i < 2; ++_i) \
        __builtin_amdgcn_global_load_lds((const unsigned*)((const char*)(gbase) + (voff)[_i]), (PG8_LAS unsigned*)(lds + (bufoff) + ldsw + _i * 8192), 16, 0, 0); } while (0)
#define PG8_LDA(dst, b, h) do { _Pragma("unroll") for (int m = 0; m < 4; ++m) _Pragma("unroll") for (int k = 0; k < 2; ++k) dst[m][k] = *(const PG8_LAS bf16x8*)(lds + PG8_SA(b, h) + aoff + m * 2048 + k * 1024); } while (0)
#define PG8_LDB(dst, b, h) do { _Pragma("unroll") for (int n = 0; n < 2; ++n) _Pragma("unroll") for (int k = 0; k < 2; ++k) dst[n][k] = *(const PG8_LAS bf16x8*)(lds + PG8_SB(b, h) + boff + n * 2048 + k * 1024); } while (0)
#define PG8_MMA(ai, bj, At, Bt) do { __builtin_amdgcn_s_setprio(1); _Pragma("unroll") for (int m = 0; m < 4; ++m) _Pragma("unroll") for (int n = 0; n < 2; ++n) _Pragma("unroll") for (int k = 0; k < 2; ++k) \
        acc[ai][bj][m][n] = __builtin_amdgcn_mfma_f32_16x16x32_bf16(Bt[n][k], At[m][k], acc[ai][bj][m][n], 0, 0, 0); __builtin_amdgcn_s_setprio(0); } while (0)
#define PG8_WAIT_V(n) asm volatile("s_waitcnt vmcnt(" #n ")" ::: "memory")
#define PG8_WAIT_L(n) asm volatile("s_waitcnt lgkmcnt(" #n ")" ::: "memory")
#define PG8_BAR __builtin_amdgcn_s_barrier()
#define PG8_SCHED __builtin_amdgcn_sched_barrier(0)
    Unit cur, nxt; int ui = 0;
    if (!S.next(0, cur)) return;
    f32x4 acc[2][2][4][2];
    if constexpr (Epi::INIT_ACC) E.init(acc, cur, wr, wc, fr, fq);
    else {
#pragma unroll
    for (int a = 0; a < 2; ++a)
#pragma unroll
        for (int b = 0; b < 2; ++b)
#pragma unroll
            for (int m = 0; m < 4; ++m)
#pragma unroll
                for (int n = 0; n < 2; ++n) acc[a][b][m][n] = (f32x4){0.f, 0.f, 0.f, 0.f};
    }
    bf16x8 At[4][2], B0[2][2], B1[2][2];
    const char* cA = (const char*)g.A + (size_t)cur.pm * tstep; const char* cB = (const char*)g.Bt + (size_t)cur.pn * tstep;
    S.a_ready(cur);
    if constexpr (SP2) {
        PG8_STAGE(PG8_SB(0, 0), cB, voffB); PG8_STAGE(PG8_SB(0, 1), cB + hstep, voffB); PG8_STAGE(PG8_SA(0, 0), cA, voffA); PG8_STAGE(PG8_SA(0, 1), cA + hstep, voffA);
        if (wr == 1) PG8_BAR;
        PG8_WAIT_V(2); PG8_BAR;
        PG8_STAGE(PG8_SB(1, 0), cB + kstep, voffB); PG8_STAGE(PG8_SA(1, 0), cA + kstep, voffA); PG8_STAGE(PG8_SB(1, 1), cB + hstep + kstep, voffB);
        PG8_WAIT_V(6); PG8_BAR;
    } else {
        PG8_STAGE(PG8_SB(0, 0), cB, voffB); PG8_STAGE(PG8_SA(0, 0), cA, voffA); PG8_STAGE(PG8_SB(0, 1), cB + hstep, voffB); PG8_STAGE(PG8_SA(0, 1), cA + hstep, voffA);
        if (wr == 1) PG8_BAR;
        PG8_WAIT_V(4); PG8_BAR;
        PG8_STAGE(PG8_SB(1, 0), cB + kstep, voffB); PG8_STAGE(PG8_SA(1, 0), cA + kstep, voffA); PG8_STAGE(PG8_SB(1, 1), cB + hstep + kstep, voffB);
        PG8_WAIT_V(6); PG8_BAR;
    }
    for (;;) {
        const bool has_next = S.next(ui + 1, nxt);
        const char* nA = has_next ? (const char*)g.A + (size_t)nxt.pm * tstep : cA; const char* nB = has_next ? (const char*)g.Bt + (size_t)nxt.pn * tstep : cB;
        for (int t = 0; t < nt; t += 2) {
            const bool last = (t == nt - 2);
            const char* a1 = cA + (size_t)(t + 1) * kstep;
            const char* a2 = last ? nA : cA + (size_t)(t + 2) * kstep; const char* b2 = last ? nB : cB + (size_t)(t + 2) * kstep;
            const char* a3 = a2 + kstep; const char* b3 = b2 + kstep;
            if (last && has_next) S.a_ready(nxt);
            if constexpr (SP2) {
            PG8_LDB(B0, 0, 0); PG8_LDB(B1, 0, 1); PG8_SCHED; PG8_LDA(At, 0, 0); PG8_STAGE(PG8_SA(1, 1), a1 + hstep, voffA);
            PG8_WAIT_V(8); PG8_WAIT_L(0); PG8_BAR; PG8_MMA(0, 0, At, B0); PG8_MMA(0, 1, At, B1); PG8_BAR; PG8_SCHED;
            PG8_LDA(At, 0, 1); PG8_STAGE(PG8_SB(0, 0), b2, voffB); PG8_STAGE(PG8_SB(0, 1), b2 + hstep, voffB); PG8_STAGE(PG8_SA(0, 0), a2, voffA);
            PG8_WAIT_V(8); PG8_WAIT_L(0); PG8_BAR; PG8_MMA(1, 0, At, B0); PG8_MMA(1, 1, At, B1); PG8_BAR; PG8_SCHED;
            PG8_LDB(B0, 1, 0); PG8_LDB(B1, 1, 1); PG8_SCHED; PG8_LDA(At, 1, 0); PG8_STAGE(PG8_SA(0, 1), a2 + hstep, voffA);
            PG8_WAIT_V(8); PG8_WAIT_L(0); PG8_BAR; PG8_MMA(0, 0, At, B0); PG8_MMA(0, 1, At, B1); PG8_BAR; PG8_SCHED;
            PG8_LDA(At, 1, 1); PG8_STAGE(PG8_SB(1, 0), b3, voffB); PG8_STAGE(PG8_SB(1, 1), b3 + hstep, voffB); PG8_STAGE(PG8_SA(1, 0), a3, voffA);
            PG8_WAIT_V(8); PG8_WAIT_L(0); PG8_BAR; PG8_MMA(1, 0, At, B0); PG8_MMA(1, 1, At, B1); PG8_BAR; PG8_SCHED;
            } else {
            PG8_LDB(B0, 0, 0); PG8_SCHED; PG8_LDA(At, 0, 0); PG8_STAGE(PG8_SA(1, 1), a1 + hstep, voffA);
            PG8_WAIT_L(8); PG8_BAR; PG8_WAIT_L(0); PG8_MMA(0, 0, At, B0); PG8_BAR; PG8_SCHED;
            PG8_LDB(B1, 0, 1); PG8_STAGE(PG8_SB(0, 0), b2, voffB);
            PG8_BAR; PG8_WAIT_L(0); PG8_MMA(0, 1, At, B1); PG8_BAR;
            PG8_LDA(At, 0, 1); PG8_STAGE(PG8_SA(0, 0), a2, voffA);
            PG8_BAR; PG8_WAIT_L(0); PG8_MMA(1, 0, At, B0); PG8_BAR; PG8_SCHED;
            PG8_STAGE(PG8_SB(0, 1), b2 + hstep, voffB);
            PG8_WAIT_V(6); PG8_BAR; PG8_MMA(1, 1, At, B1); PG8_BAR;
            PG8_LDB(B0, 1, 0); PG8_SCHED; PG8_LDA(At, 1, 0); PG8_STAGE(PG8_SA(0, 1), a2 + hstep, voffA);
            PG8_WAIT_L(8); PG8_BAR; PG8_WAIT_L(0); PG8_MMA(0, 0, At, B0); PG8_BAR; PG8_SCHED;
            PG8_LDB(B1, 1, 1); PG8_STAGE(PG8_SB(1, 0), b3, voffB);
            PG8_BAR; PG8_WAIT_L(0); PG8_MMA(0, 1, At, B1); PG8_BAR;
            PG8_LDA(At, 1, 1); PG8_STAGE(PG8_SA(1, 0), a3, voffA);
            PG8_BAR; PG8_WAIT_L(0); PG8_MMA(1, 0, At, B0); PG8_BAR; PG8_SCHED;
            PG8_STAGE(PG8_SB(1, 1), b3 + hstep, voffB);
            PG8_WAIT_V(6); PG8_BAR; PG8_MMA(1, 1, At, B1); PG8_BAR;
            }
        }
        if constexpr (ALIGN_EPI) { if (wr == 0) PG8_BAR; }
        if constexpr (!Epi::AFTER_DRAIN) { E(acc, cur, wr, wc, fr, fq); S.done(cur); }
        if (!has_next) break;
        if constexpr (Epi::INIT_ACC) E.init(acc, nxt, wr, wc, fr, fq);
        else {
#pragma unroll
        for (int a = 0; a < 2; ++a)
#pragma unroll
            for (int b = 0; b < 2; ++b)
#pragma unroll
                for (int m = 0; m < 4; ++m)
#pragma unroll
                    for (int n = 0; n < 2; ++n) acc[a][b][m][n] = (f32x4){0.f, 0.f, 0.f, 0.f};
        }
        cur = nxt; cA = nA; cB = nB; ++ui;
        if constexpr (ALIGN_EPI) { if (wr == 1) PG8_BAR; }
    }
    PG8_WAIT_V(0);
    if constexpr (!ALIGN_EPI) { if (wr == 0) PG8_BAR; }
    PG8_BAR;
    if constexpr (Epi::AFTER_DRAIN) { E.fused(acc, cur, wr, wc, fr, fq, lds, wid, lane); S.done(cur); }
#undef PG8_SA
#undef PG8_SB
#undef PG8_STAGE
#undef PG8_LDA
#undef PG8_LDB
#undef PG8_MMA
#undef PG8_WAIT_V
#undef PG8_WAIT_L
#undef PG8_BAR
#undef PG8_SCHED
}
}

#define XB_TMO      128
#define XB_XCNT(j)  (256  + 64 * (j))
#define XB_XSUB(j)  (1280 + 64 * (j))
#define XB_XGEN(j)  (2304 + 64 * (j))
#define XB_TOP      3328
#define XB_TOPGEN   3392
#define XCD_BAR_WORDS 3456
#define XB_SPIN_CAP (1u << 18)
#define LAS __attribute__((address_space(3)))

__device__ __forceinline__ unsigned xb_ld(unsigned* p)              { return __hip_atomic_load(p, __ATOMIC_RELAXED, __HIP_MEMORY_SCOPE_AGENT); }
__device__ __forceinline__ unsigned xb_add(unsigned* p, unsigned v) { return __hip_atomic_fetch_add(p, v, __ATOMIC_RELAXED, __HIP_MEMORY_SCOPE_AGENT); }
__device__ __forceinline__ unsigned xb_xcc_id() { return (unsigned)__builtin_amdgcn_s_getreg((3 << 11) | 20) & 0xFu; }
#define XB_SPIN(cond, bar) do { unsigned _sp = 0; while (cond) { __builtin_amdgcn_s_sleep(1); \
    if ((++_sp & 255u) == 0u) { if (xb_ld(&(bar)[XB_TMO])) break; if (_sp > XB_SPIN_CAP) { atomicAdd(&(bar)[XB_TMO], 1u); break; } } } } while (0)

struct XcdBarrier {
    unsigned* bar; unsigned x;
    volatile LAS unsigned* st;
};

__device__ __forceinline__ XcdBarrier xcd_barrier_post(unsigned* bar, volatile LAS unsigned* st) {
    XcdBarrier b; b.bar = bar; b.x = xb_xcc_id(); b.st = st;
    if (threadIdx.x == 0) (void)xb_add(&bar[XB_XCNT(b.x)], 1u);
    return b;
}
__device__ __forceinline__ void xcd_barrier_complete(unsigned* bar, unsigned x, unsigned& nloc, unsigned& nx) {
    const unsigned G = gridDim.x * gridDim.y * gridDim.z;
    unsigned sum, cnt, mine, sp = 0u;
    for (;;) {
        sum = 0u; cnt = 0u; mine = 0u;
#pragma unroll
        for (unsigned j = 0; j < 16; ++j) { const unsigned c = xb_ld(&bar[XB_XCNT(j)]); sum += c; cnt += (c > 0u) ? 1u : 0u; mine = (j == x) ? c : mine; }
        if (sum == G) break;
        __builtin_amdgcn_s_sleep(1);
        if ((++sp & 255u) == 0u) { if (xb_ld(&bar[XB_TMO])) break; if (sp > XB_SPIN_CAP) { atomicAdd(&bar[XB_TMO], 1u); break; } }
    }
    nloc = mine > 0u ? mine : 1u; nx = cnt > 0u ? cnt : 1u;
}

__device__ __forceinline__ void xcd_barrier(const XcdBarrier& b) {
    asm volatile("s_waitcnt vmcnt(0)" ::: "memory");
    __syncthreads();
    if (threadIdx.x == 0) {
        unsigned* bar = b.bar;
        __builtin_amdgcn_s_waitcnt(0);
        unsigned nloc = b.st[0], nx = b.st[1];
        if (nloc == 0u) { xcd_barrier_complete(bar, b.x, nloc, nx); b.st[0] = nloc; b.st[1] = nx; }
        const unsigned old = xb_add(&bar[XB_XSUB(b.x)], 1u);
        const unsigned gen = old / nloc;
        if (old + 1u == (gen + 1u) * nloc) {
            __builtin_amdgcn_fence(__ATOMIC_RELEASE, "agent");
            asm volatile("s_waitcnt vmcnt(0)" ::: "memory");
            const unsigned og = xb_add(&bar[XB_TOP], 1u);
            const unsigned tg = og / nx;
            if (og + 1u == (tg + 1u) * nx) xb_add(&bar[XB_TOPGEN], 1u);
            else XB_SPIN(xb_ld(&bar[XB_TOPGEN]) == tg, bar);
            __builtin_amdgcn_fence(__ATOMIC_ACQUIRE, "agent");
            xb_add(&bar[XB_XGEN(b.x)], 1u);
            asm volatile("s_waitcnt vmcnt(0)" ::: "memory");
        } else {
            XB_SPIN(xb_ld(&bar[XB_XGEN(b.x)]) == gen, bar);
            __builtin_amdgcn_fence(__ATOMIC_ACQUIRE, "agent");
            asm volatile("s_waitcnt vmcnt(0)" ::: "memory");
        }
    }
    __syncthreads();
}

using pg8::bf16_t; using pg8::bf16x8; using pg8::f32x4; using pg8::u32x4; using pg8::cvt_pk_bf16;
typedef float f32x16 __attribute__((ext_vector_type(16)));
typedef unsigned u32x2 __attribute__((ext_vector_type(2)));

constexpr int DM = 1024, NB = 4, SEQ = 4096, NTP = NB * SEQ, DB = 128, DS = 8, NTS = DB * DS, MT = NTP + NTS;
constexpr int LA = 2048, LBW = 128, NQKV = 2304, NPQ = 2048, NEXP = 16384;
constexpr float EPS = 1e-6f, LOG2E = 1.4426950408889634f, QSCALE = 0.125f * LOG2E;
constexpr int NTHREADS = 512, NWAVES = 8;
constexpr int LDS_BYTES = 158720;
constexpr int LDS_BARW = LDS_BYTES - 16;

constexpr size_t O_YP = 0, O_YS = 16777216, O_AKP = 17825792, O_AVP = 22020096, O_BKP = 26214400, O_BVP = 26279936,
                 O_AKS = 26345472, O_AVS = 160563200, O_BKS = 294780928, O_BVS = 296878080, O_END = 298975232;

constexpr size_t WS_BAR = 0, WS_ROWSS = 16384, WS_ZERO_BYTES = WS_ROWSS + (size_t)MT * 4;
constexpr size_t WS_RSTD1 = WS_ZERO_BYTES;
constexpr size_t WS_XB  = WS_RSTD1 + (size_t)MT * 4;
constexpr size_t WS_BT1 = WS_XB + (size_t)MT * DM * 2;
constexpr size_t WS_BT2 = WS_BT1 + (size_t)NQKV * DM * 2;
constexpr size_t WS_BT3 = WS_BT2 + (size_t)DM * DM * 2;
constexpr size_t WS_U8  = WS_BT3 + (size_t)NPQ * DM * 2;
constexpr size_t WS_V8  = WS_U8 + (size_t)NEXP * DM;
constexpr size_t WS_USC = WS_V8 + (size_t)NEXP * DM;
constexpr size_t WS_VSC = WS_USC + (size_t)NEXP * 4;
constexpr size_t WS_QA  = WS_VSC + (size_t)NEXP * 4;
constexpr size_t WS_KA  = WS_QA + (size_t)MT * 512 * 2;
constexpr size_t WS_VAT = WS_KA + (size_t)MT * 512 * 2;
constexpr size_t WS_QB  = WS_VAT + (size_t)MT * 512 * 2;
constexpr size_t WS_KB  = WS_QB + (size_t)MT * 512 * 2;
constexpr size_t WS_VBT = WS_KB + (size_t)MT * 128 * 2;
constexpr size_t WS_CAT = WS_VBT + (size_t)MT * 128 * 2;
constexpr size_t WS_H   = WS_CAT + (size_t)MT * DM * 2;
constexpr size_t WS_HB  = WS_H + (size_t)MT * DM * 4;
constexpr size_t WS_S   = WS_HB + (size_t)MT * DM * 2;
constexpr size_t WS_SPART = WS_S + (size_t)MT * NPQ * 4;
constexpr size_t WS_PEERK = WS_SPART + (size_t)DB * 2 * 40960;
constexpr size_t WS_PD = WS_PEERK + (size_t)MT * 1024;
constexpr size_t WS_COEF = WS_PD + (size_t)MT * 4096;
constexpr size_t WS_END = WS_COEF + (size_t)MT * 512;
constexpr size_t SLICE_BYTES = (size_t)NEXP * 128;
static_assert(WS_RSTD1 % 256 == 0 && WS_XB % 256 == 0 && WS_BT1 % 256 == 0 && WS_S % 256 == 0 && WS_PEERK % 256 == 0 && WS_PD % 256 == 0 && WS_U8 % 256 == 0, "alignment");

struct Args { const float* in[19]; float* out; unsigned char* ws; int ph_lo, ph_hi; };

__device__ __forceinline__ float wave_sum(float v) {
#pragma unroll
    for (int o = 32; o >= 1; o >>= 1) v += __shfl_xor(v, o);
    return v;
}
__device__ __forceinline__ float wave_max(float v) {
#pragma unroll
    for (int o = 32; o >= 1; o >>= 1) v = fmaxf(v, __shfl_xor(v, o));
    return v;
}
__device__ __forceinline__ float readlane_f(float v, int l) { return __uint_as_float((unsigned)__builtin_amdgcn_readlane((int)__float_as_uint(v), l)); }
__device__ __forceinline__ float bf_lo(unsigned w) { return __uint_as_float(w << 16); }
__device__ __forceinline__ float bf_hi(unsigned w) { return __uint_as_float(w & 0xffff0000u); }
__device__ __forceinline__ float alibi_slope(int h) { return exp2f(-(float)(h + 1)); }

__device__ __forceinline__ void late_prologue(const Args& a, LAS unsigned char* lds, LAS unsigned* rbc, unsigned& ep, const int aw);
__device__ __forceinline__ void p0_prologue(const Args& a, LAS unsigned char* lds) {
    const int tid = threadIdx.x, lane = tid & 63, wave = tid >> 6, G = gridDim.x, bid = blockIdx.x;
    unsigned char* ws = a.ws;
    {
        bf16_t* XB = (bf16_t*)(ws + WS_XB); float* rstd = (float*)(ws + WS_RSTD1);
        const int NWX = (CONV_IN_P1 && G == 256) ? 4 : NWAVES;
        const int rstep = G * NWX;
        int row = bid * NWX + wave;
        if (wave < NWX) {
        f32x4 v[4];
        if (row < MT) { const float* x = row < NTP ? a.in[0] + (size_t)row * DM : a.in[1] + (size_t)(row - NTP) * DM;
#pragma unroll
            for (int k = 0; k < 4; ++k) v[k] = *(const f32x4*)(x + k * 256 + lane * 4); }
        for (; row < MT; row += rstep) {
            f32x4 vn[4];
            { const int rn = min(row + rstep, MT - 1); const float* x = rn < NTP ? a.in[0] + (size_t)rn * DM : a.in[1] + (size_t)(rn - NTP) * DM;
#pragma unroll
              for (int k = 0; k < 4; ++k) vn[k] = *(const f32x4*)(x + k * 256 + lane * 4); }
            float ss = 0.f;
#pragma unroll
            for (int k = 0; k < 4; ++k) ss += v[k][0] * v[k][0] + v[k][1] * v[k][1] + v[k][2] * v[k][2] + v[k][3] * v[k][3];
            ss = wave_sum(ss);
            if (lane == 0) rstd[row] = rsqrtf(ss * (1.0f / DM) + EPS);
#pragma unroll
            for (int k = 0; k < 4; ++k) { u32x2 w; w.x = cvt_pk_bf16(v[k][0], v[k][1]); w.y = cvt_pk_bf16(v[k][2], v[k][3]); *(u32x2*)(XB + (size_t)row * DM + k * 256 + lane * 4) = w; }
#pragma unroll
            for (int k = 0; k < 4; ++k) v[k] = vn[k];
        }
        } else { unsigned ep = 0u; late_prologue(a, lds, (LAS unsigned*)(lds + LDS_BARW - 16) + 1, ep, wave - 4); }
        __syncthreads();
    }
    {
        LAS float* T = (LAS float*)lds;
        bf16_t* BT1 = (bf16_t*)(ws + WS_BT1); bf16_t* BT2 = (bf16_t*)(ws + WS_BT2);
        const int nt1 = (NQKV / 64) * 16, nt2 = 0;
        for (int t = bid; t < nt1 + nt2; t += G) {
            const bool first = t < nt1; const int t2 = first ? t : t - nt1;
            const int ct = t2 >> 4, dt = t2 & 15;
            const float* W = first ? a.in[7] : a.in[13]; const int ldw = first ? NQKV : DM; bf16_t* BT = first ? BT1 : BT2;
            const int ty = tid >> 6, tx = tid & 63;
#pragma unroll
            for (int k = 0; k < 8; ++k) { const int dd = ty + 8 * k; float w = W[(size_t)(dt * 64 + dd) * ldw + ct * 64 + tx]; if (first) w *= a.in[6][dt * 64 + dd]; T[dd * 65 + tx] = w; }
            __syncthreads();
            const int cc = tid >> 3, dsg = tid & 7, c = ct * 64 + cc;
            const int memrow = first ? (c & ~255) + ((c & 63) >> 5) * 128 + ((c & 255) >> 6) * 32 + (c & 31) : c;
            u32x4 w; w.x = cvt_pk_bf16(T[(8 * dsg + 0) * 65 + cc], T[(8 * dsg + 1) * 65 + cc]); w.y = cvt_pk_bf16(T[(8 * dsg + 2) * 65 + cc], T[(8 * dsg + 3) * 65 + cc]);
            w.z = cvt_pk_bf16(T[(8 * dsg + 4) * 65 + cc], T[(8 * dsg + 5) * 65 + cc]); w.w = cvt_pk_bf16(T[(8 * dsg + 6) * 65 + cc], T[(8 * dsg + 7) * 65 + cc]);
            *(u32x4*)(BT + (size_t)memrow * DM + dt * 64 + 8 * dsg) = w;
            __syncthreads();
        }
    }
}

struct EpiQKV {
    static constexpr bool PERM = true, AFTER_DRAIN = false, INIT_ACC = false;
    const float* rstd; const float* gqa; const float* gka; const float* gqb; const float* gkb;
    bf16_t* QA; bf16_t* KA; bf16_t* VAT; bf16_t* QB; bf16_t* KB; bf16_t* VBT; float* out;
    __device__ __forceinline__ void operator()(const f32x4 (&acc)[2][2][4][2], const pg8::Unit& u, int wr, int wc, int fr, int fq) const {
        const int hd = u.pn * 4 + wc;
        const int type = hd < 8 ? 0 : hd < 16 ? 1 : hd < 24 ? 2 : hd < 32 ? 3 : hd < 34 ? 4 : 5;
        const int hl = type == 0 ? hd : type == 1 ? hd - 8 : type == 2 ? hd - 16 : type == 3 ? hd - 24 : type == 4 ? hd - 32 : hd - 34;
        const float* gv = type == 0 ? gqa : type == 1 ? gka : type == 3 ? gqb : type == 4 ? gkb : nullptr;
        const float qs = (type == 0 || type == 3) ? QSCALE : 1.0f;
        f32x4 gg[2][2];
#pragma unroll
        for (int bj = 0; bj < 2; ++bj)
#pragma unroll
            for (int n = 0; n < 2; ++n) gg[bj][n] = gv ? *(const f32x4*)(gv + 32 * bj + 8 * fq + 4 * n) : (f32x4){1.f, 1.f, 1.f, 1.f};
#pragma unroll
        for (int ai = 0; ai < 2; ++ai)
#pragma unroll
            for (int m = 0; m < 4; ++m) {
                const int row = u.pm * 256 + ai * 128 + wr * 64 + m * 16 + fr;
                const float rs = rstd[row];
                f32x4 v[2][2]; float ss = 0.f;
#pragma unroll
                for (int bj = 0; bj < 2; ++bj)
#pragma unroll
                    for (int n = 0; n < 2; ++n) { v[bj][n] = acc[ai][bj][m][n] * rs; ss += v[bj][n][0] * v[bj][n][0] + v[bj][n][1] * v[bj][n][1] + v[bj][n][2] * v[bj][n][2] + v[bj][n][3] * v[bj][n][3]; }
                if (gv) {
                    ss += __shfl_xor(ss, 16); ss += __shfl_xor(ss, 32);
                    const float rn = rsqrtf(ss * (1.0f / 64.0f) + EPS) * qs;
#pragma unroll
                    for (int bj = 0; bj < 2; ++bj)
#pragma unroll
                        for (int n = 0; n < 2; ++n) v[bj][n] = v[bj][n] * rn * gg[bj][n];
                }
                const bool samp = row >= NTP;
                const int b = samp ? (row - NTP) >> 3 : row >> 12, pos = samp ? (row - NTP) & 7 : row & 4095;
                u32x4 pk[2];
#pragma unroll
                for (int bj = 0; bj < 2; ++bj) { pk[bj].x = cvt_pk_bf16(v[bj][0][0], v[bj][0][1]); pk[bj].y = cvt_pk_bf16(v[bj][0][2], v[bj][0][3]); pk[bj].z = cvt_pk_bf16(v[bj][1][0], v[bj][1][1]); pk[bj].w = cvt_pk_bf16(v[bj][1][2], v[bj][1][3]); }
                if (type == 0 || type == 3) {
                    bf16_t* dst = (type == 0 ? QA : QB) + (size_t)row * 512 + hl * 64 + 8 * fq;
                    *(u32x4*)dst = pk[0]; *(u32x4*)(dst + 32) = pk[1];
                } else if (type == 1 || type == 4) {
                    bf16_t* dst = type == 1 ? KA + (size_t)row * 512 + hl * 64 + 8 * fq : KB + (size_t)row * 128 + hl * 64 + 8 * fq;
                    *(u32x4*)dst = pk[0]; *(u32x4*)(dst + 32) = pk[1];
                    float* fo = nullptr;
                    if (type == 1) { if (samp) fo = out + O_AKS + ((size_t)(b * LA + LA - DS + pos) * 8 + hl) * 64; else if (pos >= SEQ - LA) fo = out + O_AKP + ((size_t)(b * LA + pos - (SEQ - LA)) * 8 + hl) * 64; }
                    else { if (samp) fo = out + O_BKS + ((size_t)(b * LBW + LBW - DS + pos) * 2 + hl) * 64; else if (pos >= SEQ - LBW) fo = out + O_BKP + ((size_t)(b * LBW + pos - (SEQ - LBW)) * 2 + hl) * 64; }
                    if (fo) {
#pragma unroll
                        for (int bj = 0; bj < 2; ++bj)
#pragma unroll
                            for (int n = 0; n < 2; ++n) *(f32x4*)(fo + 32 * bj + 8 * fq + 4 * n) = v[bj][n];
                    }
                } else {
                    bf16_t* dst = type == 2 ? VAT + (size_t)row * 512 + hl * 64 + 8 * fq : VBT + (size_t)row * 128 + hl * 64 + 8 * fq;
                    *(u32x4*)dst = pk[0]; *(u32x4*)(dst + 32) = pk[1];
                    float* fo = nullptr;
                    if (type == 2) { if (samp) fo = out + O_AVS + ((size_t)(b * LA + LA - DS + pos) * 8 + hl) * 64; else if (pos >= SEQ - LA) fo = out + O_AVP + ((size_t)(b * LA + pos - (SEQ - LA)) * 8 + hl) * 64; }
                    else { if (samp) fo = out + O_BVS + ((size_t)(b * LBW + LBW - DS + pos) * 2 + hl) * 64; else if (pos >= SEQ - LBW) fo = out + O_BVP + ((size_t)(b * LBW + pos - (SEQ - LBW)) * 2 + hl) * 64; }
                    if (fo) {
#pragma unroll
                        for (int bj = 0; bj < 2; ++bj)
#pragma unroll
                            for (int n = 0; n < 2; ++n) *(f32x4*)(fo + 32 * bj + 8 * fq + 4 * n) = v[bj][n];
                    }
                }
            }
    }
};
struct EpiH {
    static constexpr bool PERM = false, AFTER_DRAIN = false, INIT_ACC = true;
    const float* x0; const float* x1; float* H; bf16_t* HB; float* rowss; int row0;
    __device__ __forceinline__ void init(f32x4 (&acc)[2][2][4][2], const pg8::Unit& u, int wr, int wc, int fr, int fq) const {
#pragma unroll
        for (int ai = 0; ai < 2; ++ai)
#pragma unroll
            for (int m = 0; m < 4; ++m) {
                const int row = row0 + u.pm * 256 + ai * 128 + wr * 64 + m * 16 + fr;
                const float* xr = row < NTP ? x0 + (size_t)row * DM : x1 + (size_t)(row - NTP) * DM;
#pragma unroll
                for (int bj = 0; bj < 2; ++bj)
#pragma unroll
                    for (int n = 0; n < 2; ++n) acc[ai][bj][m][n] = *(const f32x4*)(xr + u.pn * 256 + bj * 128 + wc * 32 + n * 16 + 4 * fq);
            }
    }
    __device__ __forceinline__ void operator()(const f32x4 (&acc)[2][2][4][2], const pg8::Unit& u, int wr, int wc, int fr, int fq) const {
#pragma unroll
        for (int ai = 0; ai < 2; ++ai)
#pragma unroll
            for (int m = 0; m < 4; ++m) {
                const int row = row0 + u.pm * 256 + ai * 128 + wr * 64 + m * 16 + fr;
                float ss = 0.f;
#pragma unroll
                for (int bj = 0; bj < 2; ++bj)
#pragma unroll
                    for (int n = 0; n < 2; ++n) {
                        const int col = u.pn * 256 + bj * 128 + wc * 32 + n * 16 + 4 * fq;
                        const f32x4 h = acc[ai][bj][m][n];
                        *(f32x4*)(H + (size_t)row * DM + col) = h;
                        u32x2 w; w.x = cvt_pk_bf16(h[0], h[1]); w.y = cvt_pk_bf16(h[2], h[3]);
                        *(u32x2*)(HB + (size_t)row * DM + col) = w;
                        ss += h[0] * h[0] + h[1] * h[1] + h[2] * h[2] + h[3] * h[3];
                    }
                ss += __shfl_xor(ss, 16); ss += __shfl_xor(ss, 32);
                if (fq == 0) atomicAdd(rowss + row, ss);
            }
    }
};
struct EpiS {
    static constexpr bool PERM = false, AFTER_DRAIN = false, INIT_ACC = false;
    const float* rowss; float* S; int row0;
    __device__ __forceinline__ void operator()(const f32x4 (&acc)[2][2][4][2], const pg8::Unit& u, int wr, int wc, int fr, int fq) const {
#pragma unroll
        for (int ai = 0; ai < 2; ++ai)
#pragma unroll
            for (int m = 0; m < 4; ++m) {
                const int row = row0 + u.pm * 256 + ai * 128 + wr * 64 + m * 16 + fr;
                const float rs = rsqrtf(rowss[row] * (1.0f / DM) + EPS);
#pragma unroll
                for (int bj = 0; bj < 2; ++bj)
#pragma unroll
                    for (int n = 0; n < 2; ++n) {
                        const int col = u.pn * 256 + bj * 128 + wc * 32 + n * 16 + 4 * fq;
                        *(f32x4*)(S + (size_t)row * NPQ + col) = acc[ai][bj][m][n] * rs;
                    }
            }
    }
};

template <int CTRL> __device__ __forceinline__ float dpp_f(float x) { return __uint_as_float((unsigned)__builtin_amdgcn_update_dpp(0, (int)__float_as_uint(x), CTRL, 0xf, 0xf, false)); }
template <int CTRL> __device__ __forceinline__ int dpp_i(int x) { return __builtin_amdgcn_update_dpp(0, x, CTRL, 0xf, 0xf, false); }
template <int GS> __device__ __forceinline__ int grp_sum_i(int v) { v += dpp_i<0xB1>(v); v += dpp_i<0x4E>(v); if (GS == 8) v += dpp_i<0x141>(v); return v; }
template <int GS> __device__ __forceinline__ float grp_max_f(float v) { v = fmaxf(v, dpp_f<0xB1>(v)); v = fmaxf(v, dpp_f<0x4E>(v)); if (GS == 8) v = fmaxf(v, dpp_f<0x141>(v)); return v; }
template <int GS> __device__ __forceinline__ float grp_min_f(float v) { v = fminf(v, dpp_f<0xB1>(v)); v = fminf(v, dpp_f<0x4E>(v)); if (GS == 8) v = fminf(v, dpp_f<0x141>(v)); return v; }
__device__ __forceinline__ float row_max_f(float v) { v = fmaxf(v, dpp_f<0x128>(v)); v = fmaxf(v, dpp_f<0x124>(v)); v = fmaxf(v, dpp_f<0x122>(v)); v = fmaxf(v, dpp_f<0x121>(v)); return v; }
__device__ __forceinline__ float row_sum_f(float v) { v += dpp_f<0x128>(v); v += dpp_f<0x124>(v); v += dpp_f<0x122>(v); v += dpp_f<0x121>(v); return v; }


struct WT { const bf16_t* q; size_t qstride; const bf16_t* k; const bf16_t* v; size_t kstride; int i0; float slope2; };
typedef short s16x4 __attribute__((ext_vector_type(4)));
__device__ __forceinline__ void attn_tile(const WT& w, float kbound, float mfloor, LAS unsigned char* stg, f32x16 (&O)[2], float& ltot, float& Mq) {
    const int lane = threadIdx.x & 63, tq = lane & 31, g = lane >> 5;
    bf16x8 qb[4];
    float qq = 0.f;
#pragma unroll
    for (int c = 0; c < 4; ++c) {
        const u32x4 raw = *(const u32x4*)(w.q + (size_t)tq * w.qstride + 16 * c + 8 * g);
        qb[c] = __builtin_bit_cast(bf16x8, raw);
        const unsigned ww[4] = {raw.x, raw.y, raw.z, raw.w};
#pragma unroll
        for (int e = 0; e < 4; ++e) { const float lo = bf_lo(ww[e]), hi = bf_hi(ww[e]); qq += lo * lo + hi * hi; }
    }
    qq += __shfl_xor(qq, 32);
    Mq = fmaxf(sqrtf(qq) * kbound, mfloor);
#pragma unroll
    for (int dt = 0; dt < 2; ++dt)
#pragma unroll
        for (int i = 0; i < 16; ++i) O[dt][i] = 0.f;
    float lsum = 0.f;
    const int jbase = w.i0 - 128;
    const int kap = (tq & ~12) | ((tq & 8) >> 1) | ((tq & 4) << 1);
#define ATT_LOAD(KT, KK, VV) do { const int j0_ = jbase + 32 * (KT); const int jk_ = max(j0_ + kap, 0); \
        _Pragma("unroll") for (int c = 0; c < 4; ++c) KK[c] = *(const bf16x8*)(w.k + (size_t)jk_ * w.kstride + 16 * c + 8 * g); \
        _Pragma("unroll") for (int t = 0; t < 2; ++t) { const int jv_ = max(j0_ + 16 * t + (lane >> 2), 0); const bf16_t* vp_ = w.v + (size_t)jv_ * w.kstride + 16 * (lane & 3); VV[t][0] = *(const u32x4*)vp_; VV[t][1] = *(const u32x4*)(vp_ + 8); } } while (0)
    const int kt0 = max(0, (128 - w.i0) >> 5);
    bf16x8 ka[4]; u32x4 vv[2][2];
    ATT_LOAD(kt0, ka, vv);
#pragma unroll 1
    for (int kt = kt0; kt < 5; ++kt) {
        const int j0 = jbase + 32 * kt;
        bf16x8 nk[4]; u32x4 nv[2][2];
        { const int ktn = min(kt + 1, 4); ATT_LOAD(ktn, nk, nv); }
        f32x16 S;
#pragma unroll
        for (int i = 0; i < 16; ++i) S[i] = 0.f;
#pragma unroll
        for (int c = 0; c < 4; ++c) S = __builtin_amdgcn_mfma_f32_32x32x16_bf16(ka[c], qb[c], S, 0, 0, 0);
        const int dbase = tq + 128 - 32 * kt - 8 * g;
        unsigned pw[8];
#pragma unroll
        for (int i2 = 0; i2 < 8; ++i2) {
            float p[2];
#pragma unroll
            for (int e = 0; e < 2; ++e) {
                const int i = 2 * i2 + e, ko = 16 * (i >> 3) + (i & 7);
                const int dist = dbase - ko;
                const bool valid = (j0 + 8 * g + ko >= 0) && (dist >= 0) && (dist <= 128);
                const float s2 = S[i] - w.slope2 * (float)dist - Mq;
                p[e] = valid ? __builtin_amdgcn_exp2f(s2) : 0.f;
                lsum += p[e];
            }
            pw[i2] = cvt_pk_bf16(p[0], p[1]);
        }
        bf16x8 pb[2];
        { u32x4 t0 = {pw[0], pw[1], pw[2], pw[3]}, t1 = {pw[4], pw[5], pw[6], pw[7]}; pb[0] = __builtin_bit_cast(bf16x8, t0); pb[1] = __builtin_bit_cast(bf16x8, t1); }
#pragma unroll
        for (int t = 0; t < 2; ++t) {
            LAS unsigned char* wp = stg + (lane & 2) * 512 + (lane >> 2) * 64 + (lane & 1) * 32;
            *(LAS u32x4*)wp = vv[t][0]; *(LAS u32x4*)(wp + 16) = vv[t][1];
            asm volatile("" ::: "memory");
#pragma unroll
            for (int dt = 0; dt < 2; ++dt) {
                const LAS unsigned char* rp = stg + dt * 1024 + (8 * g + ((lane & 15) >> 2)) * 64 + (16 * ((lane >> 4) & 1) + 4 * (lane & 3)) * 2;
                const s16x4 lo4 = __builtin_amdgcn_ds_read_tr16_b64_v4i16((LAS s16x4*)rp), hi4 = __builtin_amdgcn_ds_read_tr16_b64_v4i16((LAS s16x4*)(rp + 256));
                const bf16x8 va = {lo4[0], lo4[1], lo4[2], lo4[3], hi4[0], hi4[1], hi4[2], hi4[3]};
                O[dt] = __builtin_amdgcn_mfma_f32_32x32x16_bf16(va, pb[t], O[dt], 0, 0, 0);
            }
            asm volatile("" ::: "memory");
        }
#pragma unroll
        for (int c = 0; c < 4; ++c) ka[c] = nk[c];
        vv[0][0] = nv[0][0]; vv[0][1] = nv[0][1]; vv[1][0] = nv[1][0]; vv[1][1] = nv[1][1];
    }
#undef ATT_LOAD
    ltot = lsum + __shfl_xor(lsum, 32);
}

template <int NBR>
__device__ __forceinline__ void sample_task(const f32x4 q4, float M, const float* kc, const float* vc, const float* kn, const float* vn, int Lc, int rstride, int i, float slope2, f32x4& O, float& l) {
    O = (f32x4){0.f, 0.f, 0.f, 0.f}; l = 0.f;
#pragma unroll 1
    for (int br = 0; br < NBR; ++br) {
        const int d = 1 << (2 * br);
#pragma unroll 1
        for (int jb = 0; jb < 136; jb += 8) {
            f32x4 k4[8], v4[8];
#pragma unroll
            for (int e = 0; e < 8; ++e) {
                const int j = min(jb + e, 128), idx = Lc + i - j * d;
                const float* kp = idx < Lc ? kc + (size_t)idx * rstride : kn + (size_t)(idx - Lc) * rstride;
                const float* vp = idx < Lc ? vc + (size_t)idx * rstride : vn + (size_t)(idx - Lc) * rstride;
                k4[e] = *(const f32x4*)kp; v4[e] = *(const f32x4*)vp;
            }
#pragma unroll
            for (int e = 0; e < 8; ++e) {
                float dot = q4[0] * k4[e][0] + q4[1] * k4[e][1] + q4[2] * k4[e][2] + q4[3] * k4[e][3];
                dot += __shfl_xor(dot, 1); dot += __shfl_xor(dot, 2); dot += __shfl_xor(dot, 4); dot += __shfl_xor(dot, 8);
                const int j = jb + e;
                const float s2 = dot - slope2 * (float)(j * d) - M;
                const float p = (j <= 128) ? __builtin_amdgcn_exp2f(s2) : 0.f;
                l += p; O = O + v4[e] * p;
            }
        }
    }
}

__device__ __forceinline__ void bar4(LAS unsigned* cnt, unsigned& epoch) {
    asm volatile("s_waitcnt vmcnt(0) lgkmcnt(0)" ::: "memory");
    epoch += 4u;
    if ((threadIdx.x & 63) == 0) {
        __hip_atomic_fetch_add(cnt, 1u, __ATOMIC_RELAXED, __HIP_MEMORY_SCOPE_WORKGROUP);
        while (__hip_atomic_load(cnt, __ATOMIC_RELAXED, __HIP_MEMORY_SCOPE_WORKGROUP) < epoch) __builtin_amdgcn_s_sleep(1);
    }
    asm volatile("" ::: "memory");
}


__device__ __forceinline__ void late_prologue(const Args& a, LAS unsigned char* lds, LAS unsigned* rbc, unsigned& ep, const int aw) {
    const int t = threadIdx.x - 256, lane = t & 63, G = gridDim.x, bid = blockIdx.x;
    unsigned char* ws = a.ws;
    {
        LAS float* T = (LAS float*)lds;
        bf16_t* BT2 = (bf16_t*)(ws + WS_BT2);
        for (int tl = bid; tl < 256; tl += G) {
            const int ct = tl >> 4, dt = tl & 15;
            const int ty = t >> 6, tx = t & 63;
#pragma unroll
            for (int k = 0; k < 16; ++k) { const int dd = ty + 4 * k; T[dd * 65 + tx] = a.in[13][(size_t)(dt * 64 + dd) * DM + ct * 64 + tx]; }
            bar4(rbc, ep);
            const int cc = t >> 2, dsg = t & 3;
#pragma unroll
            for (int hf = 0; hf < 2; ++hf) {
                const int d8 = 16 * dsg + 8 * hf;
                u32x4 w; w.x = cvt_pk_bf16(T[(d8 + 0) * 65 + cc], T[(d8 + 1) * 65 + cc]); w.y = cvt_pk_bf16(T[(d8 + 2) * 65 + cc], T[(d8 + 3) * 65 + cc]);
                w.z = cvt_pk_bf16(T[(d8 + 4) * 65 + cc], T[(d8 + 5) * 65 + cc]); w.w = cvt_pk_bf16(T[(d8 + 6) * 65 + cc], T[(d8 + 7) * 65 + cc]);
                *(u32x4*)(BT2 + (size_t)(ct * 64 + cc) * DM + dt * 64 + d8) = w;
            }
            bar4(rbc, ep);
        }
    }
    {
        LAS float* Kt = (LAS float*)lds;
        LAS float* Wt = Kt + 128 * 129;
        bf16_t* BT3 = (bf16_t*)(ws + WS_BT3);
        for (int tl = bid; tl < 256; tl += G) {
            const int hp = tl >> 4, d0 = (tl & 15) * 64;
            const float* keys = a.in[16] + (size_t)hp * 16384;
#pragma unroll
            for (int k = 0; k < 16; ++k) { const int e = (t + 256 * k) * 4; const f32x4 v = *(const f32x4*)(keys + e); const int n = e >> 7, c = e & 127;
                Kt[n * 129 + c] = v[0]; Kt[n * 129 + c + 1] = v[1]; Kt[n * 129 + c + 2] = v[2]; Kt[n * 129 + c + 3] = v[3]; }
#pragma unroll
            for (int k = 0; k < 8; ++k) { const int e = (t + 256 * k) * 4; const int dd = e >> 7, c = e & 127;
                *(LAS f32x4*)(Wt + dd * 128 + c) = *(const f32x4*)(a.in[15] + (size_t)(d0 + dd) * NPQ + hp * 128 + c); }
            bar4(rbc, ep);
            const int n = t & 127;
#pragma unroll 1
            for (int rep = 0; rep < 2; ++rep) {
                const int dq = (t >> 7) + 2 * rep;
                float acc[16];
#pragma unroll
                for (int j = 0; j < 16; ++j) acc[j] = 0.f;
                for (int c4 = 0; c4 < 32; ++c4) {
                    const float k0 = Kt[n * 129 + 4 * c4], k1 = Kt[n * 129 + 4 * c4 + 1], k2 = Kt[n * 129 + 4 * c4 + 2], k3 = Kt[n * 129 + 4 * c4 + 3];
#pragma unroll
                    for (int j = 0; j < 16; ++j) { const f32x4 w = *(const LAS f32x4*)(Wt + (dq * 16 + j) * 128 + 4 * c4); acc[j] += k0 * w[0] + k1 * w[1] + k2 * w[2] + k3 * w[3]; }
                }
                const float* gf = a.in[14] + d0 + dq * 16;
                u32x4 w0, w1;
                w0.x = cvt_pk_bf16(acc[0] * gf[0], acc[1] * gf[1]); w0.y = cvt_pk_bf16(acc[2] * gf[2], acc[3] * gf[3]); w0.z = cvt_pk_bf16(acc[4] * gf[4], acc[5] * gf[5]); w0.w = cvt_pk_bf16(acc[6] * gf[6], acc[7] * gf[7]);
                w1.x = cvt_pk_bf16(acc[8] * gf[8], acc[9] * gf[9]); w1.y = cvt_pk_bf16(acc[10] * gf[10], acc[11] * gf[11]); w1.z = cvt_pk_bf16(acc[12] * gf[12], acc[13] * gf[13]); w1.w = cvt_pk_bf16(acc[14] * gf[14], acc[15] * gf[15]);
                bf16_t* dst = BT3 + (size_t)(hp * 128 + n) * DM + d0 + dq * 16;
                *(u32x4*)dst = w0; *(u32x4*)(dst + 8) = w1;
            }
            bar4(rbc, ep);
        }
    }
}

__device__ __forceinline__ void tables_fp8(const Args& a, const int widx, const int nwtot) {
    const int lane = threadIdx.x & 63;
    unsigned char* ws = a.ws;
    {
        f32x4 gn[4];
#pragma unroll
        for (int k = 0; k < 4; ++k) gn[k] = *(const f32x4*)(a.in[14] + k * 256 + lane * 4);
        const int rstep = nwtot * 2;
        int r0 = widx * 2;
        f32x4 v[2][4];
#define TB_LOAD(R0, V) do { _Pragma("unroll") for (int rr2 = 0; rr2 < 2; ++rr2) { const int r = min((R0) + rr2, 2 * NEXP - 1); const bool second = r >= NEXP; const int rr = second ? r - NEXP : r; \
            const float* src = (second ? a.in[18] : a.in[17]) + (size_t)rr * DM; _Pragma("unroll") for (int k = 0; k < 4; ++k) V[rr2][k] = __builtin_nontemporal_load((const f32x4*)(src + k * 256 + lane * 4)); } } while (0)
        if (r0 < 2 * NEXP) TB_LOAD(r0, v);
        for (; r0 < 2 * NEXP; r0 += rstep) {
            f32x4 vn[2][4]; float mx[2];
            TB_LOAD(r0 + rstep, vn);
#pragma unroll
            for (int rr2 = 0; rr2 < 2; ++rr2) {
                const bool second = r0 + rr2 >= NEXP;
                float m = 0.f;
#pragma unroll
                for (int k = 0; k < 4; ++k) { if (!second) v[rr2][k] = v[rr2][k] * gn[k]; m = fmaxf(m, fmaxf(fmaxf(fabsf(v[rr2][k][0]), fabsf(v[rr2][k][1])), fmaxf(fabsf(v[rr2][k][2]), fabsf(v[rr2][k][3])))); }
                m = row_max_f(m); m = fmaxf(m, __shfl_xor(m, 16)); m = fmaxf(m, __shfl_xor(m, 32)); mx[rr2] = m;
            }
#pragma unroll
            for (int rr2 = 0; rr2 < 2; ++rr2) {
                const int r = r0 + rr2; const bool second = r >= NEXP; const int rr = second ? r - NEXP : r;
                const float m = mx[rr2], sc = m > 0.f ? 440.0f / m : 1.0f;
                if (lane == 0) ((float*)(ws + WS_USC))[2 * rr + (second ? 1 : 0)] = m > 0.f ? m * (1.0f / 440.0f) : 1.0f;
                unsigned char* dst = ws + (second ? WS_V8 : WS_U8) + (size_t)rr * 128 + (lane & 31) * 4;
#pragma unroll
                for (int k = 0; k < 4; ++k) { unsigned pk = __builtin_amdgcn_cvt_pk_fp8_f32(v[rr2][k][0] * sc, v[rr2][k][1] * sc, 0, false); pk = __builtin_amdgcn_cvt_pk_fp8_f32(v[rr2][k][2] * sc, v[rr2][k][3] * sc, pk, true);
                    *(unsigned*)(dst + (size_t)(2 * k + (lane >> 5)) * SLICE_BYTES) = pk; }
            }
#pragma unroll
            for (int rr2 = 0; rr2 < 2; ++rr2)
#pragma unroll
                for (int k = 0; k < 4; ++k) v[rr2][k] = vn[rr2][k];
        }
#undef TB_LOAD
    }
}

__device__ __forceinline__ void sample_mixer_b(const Args& a, const int wave0, const int NWR) {
    const int tid = threadIdx.x, lane = tid & 63, aw = __builtin_amdgcn_readfirstlane(tid >> 6) - wave0, G = gridDim.x, bid = blockIdx.x;
    unsigned char* ws = a.ws; float* out = a.out;
    const bf16_t* QB = (const bf16_t*)(ws + WS_QB); bf16_t* CAT = (bf16_t*)(ws + WS_CAT);
    const float kbB = wave_max(fabsf(a.in[11][lane])) * 8.0f * 1.01f;
    {
        for (int task = bid * NWR + aw; task < DB * DS * 2; task += G * NWR) {
            const int b = task >> 4, i = (task >> 1) & 7, kv = task & 1, hq = 4 * kv + (lane >> 4), dl = 4 * (lane & 15);
            const int row = NTP + b * DS + i;
            const u32x2 qr = *(const u32x2*)(QB + (size_t)row * 512 + hq * 64 + dl);
            const f32x4 q4 = {bf_lo(qr.x), bf_hi(qr.x), bf_lo(qr.y), bf_hi(qr.y)};
            const float qq = row_sum_f(q4[0] * q4[0] + q4[1] * q4[1] + q4[2] * q4[2] + q4[3] * q4[3]);
            const float sink2 = a.in[12][hq] * LOG2E;
            const float M = fmaxf(sqrtf(qq) * kbB, sink2);
            const size_t co = ((size_t)b * LBW * 2 + kv) * 64 + dl, no = ((size_t)(b * LBW + LBW - DS) * 2 + kv) * 64 + dl;
            f32x4 O; float l;
            sample_task<1>(q4, M, a.in[4] + co, a.in[5] + co, out + O_BKS + no, out + O_BVS + no, LBW, 128, i, alibi_slope(hq) * LOG2E, O, l);
            l += __builtin_amdgcn_exp2f(sink2 - M);
            const float inv = 1.0f / l;
            u32x2 w; w.x = cvt_pk_bf16(O[0] * inv, O[1] * inv); w.y = cvt_pk_bf16(O[2] * inv, O[3] * inv);
            *(u32x2*)(CAT + (size_t)row * DM + 512 + hq * 64 + dl) = w;
        }
        {
            const size_t gtid = (size_t)bid * (NWR * 64) + (tid - wave0 * 64), gstr = (size_t)G * (NWR * 64);
            const size_t perB = (size_t)(LBW - DS) * 128 / 4, totB = perB * DB;
            for (int t = 0; t < 2; ++t) {
                const f32x4* src = (const f32x4*)a.in[4 + t]; f32x4* dst = (f32x4*)(out + (t ? O_BVS : O_BKS));
                for (size_t i = gtid; i < totB; i += gstr) {
                    const size_t b = i / perB, off = i - b * perB;
                    const f32x4 v = __builtin_nontemporal_load(src + b * (LBW * 128 / 4) + DS * 128 / 4 + off);
                    __builtin_nontemporal_store(v, dst + b * (LBW * 128 / 4) + off);
                }
            }
        }
    }
}

__device__ __forceinline__ void p2_attention(const Args& a, LAS unsigned char* lds) {
    const int tid = threadIdx.x, lane = tid & 63, wave = __builtin_amdgcn_readfirstlane(tid >> 6), G = gridDim.x, bid = blockIdx.x;
    unsigned char* ws = a.ws; float* out = a.out;
    const bf16_t* QA = (const bf16_t*)(ws + WS_QA); const bf16_t* KA = (const bf16_t*)(ws + WS_KA); const bf16_t* VA = (const bf16_t*)(ws + WS_VAT);
    const bf16_t* QB = (const bf16_t*)(ws + WS_QB); const bf16_t* KB = (const bf16_t*)(ws + WS_KB); const bf16_t* VBN = (const bf16_t*)(ws + WS_VBT);
    bf16_t* CAT = (bf16_t*)(ws + WS_CAT);
    LAS unsigned* rb = (LAS unsigned*)(lds + LDS_BARW - 16);
    if (tid < 2) rb[tid] = 0u;
    __syncthreads();
    {
        constexpr int NWR = 8;
        const int aw = wave;
        const float kbA = wave_max(fabsf(a.in[9][lane])) * 8.0f * 1.01f, kbB = wave_max(fabsf(a.in[11][lane])) * 8.0f * 1.01f;
        const int tq = lane & 31, g = lane >> 5;
        LAS unsigned char* stg = lds + 141312 + aw * 2048;
        unsigned ep = 0u;
        for (int wt = bid * NWR + aw; wt < NB * 8 * (SEQ / 32); wt += G * NWR) {
            const int b = wt >> 10, hq = (wt >> 7) & 7, T = wt & 127, kv = hq >> 2, i0 = 32 * T;
            WT w; w.q = QB + ((size_t)(b * SEQ + i0)) * 512 + hq * 64; w.qstride = 512;
            w.k = KB + ((size_t)b * SEQ) * 128 + kv * 64; w.v = VBN + ((size_t)b * SEQ) * 128 + kv * 64; w.kstride = 128;
            w.i0 = i0; w.slope2 = alibi_slope(hq) * LOG2E;
            const float sink2 = a.in[12][hq] * LOG2E;
            f32x16 O[2]; float l, Mq;
            attn_tile(w, kbB, sink2, stg, O, l, Mq);
            l += __builtin_amdgcn_exp2f(sink2 - Mq);
            const float inv = 1.0f / l;
            bf16_t* dst = CAT + (size_t)(b * SEQ + i0 + tq) * DM + 512 + hq * 64;
#pragma unroll
            for (int dt = 0; dt < 2; ++dt)
#pragma unroll
                for (int i4 = 0; i4 < 4; ++i4) {
                    u32x2 pkw; pkw.x = cvt_pk_bf16(O[dt][4 * i4] * inv, O[dt][4 * i4 + 1] * inv); pkw.y = cvt_pk_bf16(O[dt][4 * i4 + 2] * inv, O[dt][4 * i4 + 3] * inv);
                    *(u32x2*)(dst + 32 * dt + 8 * i4 + 4 * g) = pkw;
                }
        }
        {
            LAS float* ACC = (LAS float*)lds;
            LAS float* LS = ACC + 512 * 68;
            for (int unit = bid; unit < NB * 8 * (SEQ / 512); unit += G) {
                const int b = unit >> 6, h = (unit >> 3) & 7, q0 = (unit & 7) * 512;
#pragma unroll 1
                for (int pass = 0; pass < 3; ++pass) {
                    const int sh = 2 * pass, d = 1 << sh;
#pragma unroll 1
                    for (int tt = 0; tt < 16 / NWR; ++tt) {
                        const int T = aw + NWR * tt;
                        int res, i0, qlb, qls;
                        if (pass == 0) { res = 0; i0 = q0 + 32 * T; qlb = 32 * T; qls = 1; }
                        else if (pass == 1) { res = T >> 2; i0 = (q0 >> 2) + 32 * (T & 3); qlb = 128 * (T & 3) + res; qls = 4; }
                        else { res = T; i0 = q0 >> 4; qlb = res; qls = 16; }
                        WT w; w.q = QA + ((size_t)(b * SEQ + res) + (size_t)i0 * d) * 512 + h * 64; w.qstride = (size_t)d * 512;
                        w.k = KA + ((size_t)(b * SEQ + res)) * 512 + h * 64; w.v = VA + ((size_t)(b * SEQ + res)) * 512 + h * 64; w.kstride = (size_t)d * 512;
                        w.i0 = i0; w.slope2 = alibi_slope(h) * (float)d * LOG2E;
                        f32x16 O[2]; float l, Mq;
                        attn_tile(w, kbA, -3.0e38f, stg, O, l, Mq);
                        const int ql = qlb + tq * qls;
                        LAS float* ar = ACC + ql * 68 + 4 * g;
                        if (pass == 0) {
#pragma unroll
                            for (int dt = 0; dt < 2; ++dt)
#pragma unroll
                                for (int i4 = 0; i4 < 4; ++i4) *(LAS f32x4*)(ar + 32 * dt + 8 * i4) = (f32x4){O[dt][4 * i4], O[dt][4 * i4 + 1], O[dt][4 * i4 + 2], O[dt][4 * i4 + 3]};
                            if (g == 0) LS[ql] = l;
                        } else if (pass == 1) {
#pragma unroll
                            for (int dt = 0; dt < 2; ++dt)
#pragma unroll
                                for (int i4 = 0; i4 < 4; ++i4) { const f32x4 o = *(LAS f32x4*)(ar + 32 * dt + 8 * i4); *(LAS f32x4*)(ar + 32 * dt + 8 * i4) = o + (f32x4){O[dt][4 * i4], O[dt][4 * i4 + 1], O[dt][4 * i4 + 2], O[dt][4 * i4 + 3]}; }
                            if (g == 0) LS[ql] += l;
                        } else {
                            const float inv = 1.0f / (LS[ql] + l);
                            bf16_t* dst = CAT + (size_t)(b * SEQ + q0 + ql) * DM + h * 64 + 4 * g;
#pragma unroll
                            for (int dt = 0; dt < 2; ++dt)
#pragma unroll
                                for (int i4 = 0; i4 < 4; ++i4) {
                                    const f32x4 o = *(LAS f32x4*)(ar + 32 * dt + 8 * i4);
                                    u32x2 pkw; pkw.x = cvt_pk_bf16((o[0] + O[dt][4 * i4]) * inv, (o[1] + O[dt][4 * i4 + 1]) * inv); pkw.y = cvt_pk_bf16((o[2] + O[dt][4 * i4 + 2]) * inv, (o[3] + O[dt][4 * i4 + 3]) * inv);
                                    *(u32x2*)(dst + 32 * dt + 8 * i4) = pkw;
                                }
                        }
                    }
                    if (NWR == 8) __syncthreads(); else bar4(rb + 1, ep);
                }
            }
        }
        if (CONV_IN_P1 && G == 256) { }
        else if (wave >= 4) late_prologue(a, lds, rb + 1, ep, wave - 4); else tables_fp8(a, bid * 4 + wave, G * 4);
    }
    __syncthreads();
}

__device__ __forceinline__ float gelu_erf(float x) { return 0.5f * x * (1.0f + erff(x * 0.70710678118654752f)); }

template <int GS> __device__ __forceinline__ void bisect16(const float (&x)[32], float& lo, float& hi) {
    float mx = x[0], mn = x[0];
#pragma unroll
    for (int j = 1; j < 32; ++j) { mx = fmaxf(mx, x[j]); mn = fminf(mn, x[j]); }
    hi = grp_max_f<GS>(mx); lo = grp_min_f<GS>(mn);
    bool done = false;
#pragma unroll 1
    for (int it = 0; it < 48; ++it) {
        const float t = 0.5f * (lo + hi);
        const bool conv = !(t > lo && t < hi);
        int cnt = 0;
#pragma unroll
        for (int j = 0; j < 32; ++j) cnt += (x[j] >= t) ? 1 : 0;
        cnt = grp_sum_i<GS>(cnt);
        const bool upd = !done && !conv, ex = cnt == 16, gt = cnt > 16;
        const float nlo = (ex || gt) ? t : lo, nhi = (ex || !gt) ? t : hi;
        lo = upd ? nlo : lo; hi = upd ? nhi : hi;
        done = done || conv || ex;
        if (__ballot(!done) == 0ull) break;
    }
}

__device__ __forceinline__ void peer_select(const float* S, const int row, const int lane, LAS float* sv, LAS int* si, LAS float* fvL, LAS int* eL, int& e0o, int& e1o, float& g0o, float& g1o) {
        {
            const int grp = lane >> 2, qtr = lane & 3;
            float x[32];
            const float* sp = S + (size_t)row * NPQ + grp * 128 + qtr * 32;
#pragma unroll
            for (int k = 0; k < 8; ++k) { const f32x4 v = *(const f32x4*)(sp + 4 * k); x[4 * k] = v[0]; x[4 * k + 1] = v[1]; x[4 * k + 2] = v[2]; x[4 * k + 3] = v[3]; }
            float lo, hi;
            bisect16<4>(x, lo, hi);
            int cA = 0, cB = 0;
#pragma unroll
            for (int j = 0; j < 32; ++j) { cA += (x[j] >= hi) ? 1 : 0; cB += (x[j] >= lo && x[j] < hi) ? 1 : 0; }
            const int pk = cA | (cB << 8);
            const int q0 = dpp_i<0x00>(pk), q1 = dpp_i<0x55>(pk), q2 = dpp_i<0xAA>(pk), q3 = dpp_i<0xFF>(pk);
            const int tot = q0 + q1 + q2 + q3, pre = (qtr > 0 ? q0 : 0) + (qtr > 1 ? q1 : 0) + (qtr > 2 ? q2 : 0);
            int pA = pre & 255, pB = (tot & 255) + (pre >> 8);
            asm volatile("" : "+v"(lo), "+v"(hi));
#pragma unroll
            for (int j = 0; j < 32; ++j) {
                const bool isA = x[j] >= hi, isB = !isA && x[j] >= lo;
                const int slot = isA ? pA : pB;
                if ((isA || isB) && slot < 16) { sv[grp * 16 + slot] = x[j]; si[grp * 16 + slot] = qtr * 32 + j; }
                pA += isA ? 1 : 0; pB += isB ? 1 : 0;
            }
        }
        __builtin_amdgcn_wave_barrier();
        {
            const int hd = lane >> 3, sub = lane & 7;
            const float s1a = sv[(2 * hd) * 16 + 2 * sub], s1b = sv[(2 * hd) * 16 + 2 * sub + 1];
            const int i1a = si[(2 * hd) * 16 + 2 * sub], i1b = si[(2 * hd) * 16 + 2 * sub + 1];
            float c[32]; int i2[16];
#pragma unroll
            for (int k = 0; k < 4; ++k) {
                const f32x4 v = *(const LAS f32x4*)(sv + (2 * hd + 1) * 16 + 4 * k);
                const u32x4 iv = *(const LAS u32x4*)(si + (2 * hd + 1) * 16 + 4 * k);
#pragma unroll
                for (int e = 0; e < 4; ++e) { c[4 * k + e] = s1a + v[e]; c[16 + 4 * k + e] = s1b + v[e]; }
                i2[4 * k] = (int)iv.x; i2[4 * k + 1] = (int)iv.y; i2[4 * k + 2] = (int)iv.z; i2[4 * k + 3] = (int)iv.w;
            }
            float lo, hi;
            bisect16<8>(c, lo, hi);
            int cA = 0, cB = 0;
#pragma unroll
            for (int j = 0; j < 32; ++j) { cA += (c[j] >= hi) ? 1 : 0; cB += (c[j] >= lo && c[j] < hi) ? 1 : 0; }
            const int pk = cA | (cB << 8);
            int inc = pk;
            { int t = __shfl_up(inc, 1, 8); if (sub >= 1) inc += t; t = __shfl_up(inc, 2, 8); if (sub >= 2) inc += t; t = __shfl_up(inc, 4, 8); if (sub >= 4) inc += t; }
            const int tot = __shfl(inc, 7, 8), pre = inc - pk;
            int pA = pre & 255, pB = (tot & 255) + (pre >> 8);
            asm volatile("" : "+v"(lo), "+v"(hi));
#pragma unroll
            for (int j = 0; j < 32; ++j) {
                const bool isA = c[j] >= hi, isB = !isA && c[j] >= lo;
                const int slot = isA ? pA : pB;
                if ((isA || isB) && slot < 16) { fvL[hd * 16 + slot] = c[j]; eL[hd * 16 + slot] = (j < 16 ? i1a : i1b) * 128 + i2[j & 15]; }
                pA += isA ? 1 : 0; pB += isB ? 1 : 0;
            }
        }
        __builtin_amdgcn_wave_barrier();
        const int e0 = eL[lane], e1 = eL[64 + lane];
        float g0, g1;
        { const float f0 = fvL[lane], f1 = fvL[64 + lane];
          const float p0 = __expf(f0 - row_max_f(f0)), p1 = __expf(f1 - row_max_f(f1));
          g0 = p0 / row_sum_f(p0); g1 = p1 / row_sum_f(p1); }
        e0o = e0; e1o = e1; g0o = g0; g1o = g1;
}

typedef float f32x2 __attribute__((ext_vector_type(2)));
__device__ __forceinline__ f32x2 fp8x2_lo(unsigned w) { return __builtin_amdgcn_cvt_pk_f32_fp8(w, false); }
__device__ __forceinline__ f32x2 fp8x2_hi(unsigned w) { return __builtin_amdgcn_cvt_pk_f32_fp8(w, true); }
template <int CTRL, int BANK> __device__ __forceinline__ float dpp_bank_f(float old, float x) { return __uint_as_float((unsigned)__builtin_amdgcn_update_dpp((int)__float_as_uint(old), (int)__float_as_uint(x), CTRL, 0xf, BANK, false)); }
__device__ __forceinline__ float xor4_f(float x) { float r = dpp_bank_f<0x104, 0x5>(0.f, x); return dpp_bank_f<0x114, 0xa>(r, x); }

__device__ __forceinline__ void peer_topk_w(const Args& a, LAS unsigned char* lds, const int widx, const int nwtot, const int row_lo, const int row_hi);
__device__ __forceinline__ void peer_topk(const Args& a, LAS unsigned char* lds, const int wave0, const int nw, const int row_lo, const int row_hi) {
    const int wave = __builtin_amdgcn_readfirstlane(threadIdx.x >> 6) - wave0;
    peer_topk_w(a, lds, (int)blockIdx.x * nw + wave, (int)gridDim.x * nw, row_lo, row_hi);
}
__device__ __forceinline__ void peer_topk_w(const Args& a, LAS unsigned char* lds, const int widx, const int nwtot, const int row_lo, const int row_hi) {
    const int tid = threadIdx.x, lane = tid & 63;
    unsigned char* ws = a.ws;
    const float* S = (const float*)(ws + WS_S);
    LAS float* sv = (LAS float*)(lds + __builtin_amdgcn_readfirstlane(tid >> 6) * 3072); LAS int* si = (LAS int*)(sv + 256); LAS float* fvL = (LAS float*)(si + 256); LAS int* eL = (LAS int*)(fvL + 128);
    for (int row = row_lo + widx; row < row_hi; row += nwtot) {
        int e0, e1; float g0, g1;
        peer_select(S, row, lane, sv, si, fvL, eL, e0, e1, g0, g1);
        unsigned* kp = (unsigned*)(ws + WS_PEERK) + (size_t)row * 256;
        kp[lane] = (unsigned)e0; kp[64 + lane] = (unsigned)e1; kp[128 + lane] = __float_as_uint(g0); kp[192 + lane] = __float_as_uint(g1);
        __builtin_amdgcn_wave_barrier();
    }
}

struct PeerWork { int j, q0, qstep, nq, W, OFF, row_lo; };
__device__ __forceinline__ int peer_tok(const PeerWork& w, const int q) { return w.row_lo + (q / w.W) * 16 + w.OFF + (q % w.W); }
__device__ __forceinline__ PeerWork peer_work_plain(const int wave, const int nw, const int NI, const int row_lo, const int row_hi) {
    const int bid = blockIdx.x; PeerWork w; w.j = bid & 7; w.q0 = (bid >> 3) + NI * wave; w.qstep = NI * nw; w.nq = row_hi - row_lo; w.W = 16; w.OFF = 0; w.row_lo = row_lo; return w;
}

template <bool NT>
__device__ __forceinline__ void peer_passA(const Args& a, const PeerWork w) {
    const int lane = threadIdx.x & 63;
    const int j = w.j, r = lane >> 3, sub = lane & 7;
    unsigned char* ws = a.ws;
    const unsigned char* Us = ws + WS_U8 + (size_t)j * SLICE_BYTES; const unsigned sub16 = 16u * (unsigned)sub;
    const unsigned* KP = (const unsigned*)(ws + WS_PEERK) + 16 * r;
    const float* H = (const float*)(ws + WS_H) + 128 * j + 16 * sub;
    float* PD = (float*)(ws + WS_PD) + 128 * j + 2 * lane;
    const int qs = w.qstep, ql = w.nq - 1;
    int q = w.q0;
    if (q > ql) return;
    u32x4 idv[4], ur[16]; f32x4 hv[4];
#define PA_LD(P) (NT ? __builtin_nontemporal_load((const u32x4*)(P)) : *(const u32x4*)(P))
#define PA_IDS(T) do { const unsigned* kp_ = KP + (size_t)(T) * 256; _Pragma("unroll") for (int qq = 0; qq < 4; ++qq) idv[qq] = *(const u32x4*)(kp_ + 4 * qq); } while (0)
#define PA_GATHER(T, UR, HV) do { _Pragma("unroll") for (int qq = 0; qq < 4; ++qq) { UR[4 * qq] = PA_LD(Us + (idv[qq].x * 128u + sub16)); UR[4 * qq + 1] = PA_LD(Us + (idv[qq].y * 128u + sub16)); \
            UR[4 * qq + 2] = PA_LD(Us + (idv[qq].z * 128u + sub16)); UR[4 * qq + 3] = PA_LD(Us + (idv[qq].w * 128u + sub16)); } \
        const float* hp_ = H + (size_t)(T) * DM; _Pragma("unroll") for (int qq = 0; qq < 4; ++qq) HV[qq] = *(const f32x4*)(hp_ + 4 * qq); } while (0)
    int t = peer_tok(w, q), t1 = peer_tok(w, min(q + qs, ql));
    PA_IDS(t);
    PA_GATHER(t, ur, hv);
    PA_IDS(t1);
#pragma unroll 1
    for (;; q += qs) {
        u32x4 urn[16]; f32x4 hn[4];
        PA_GATHER(t1, urn, hn);
        const int t2 = peer_tok(w, min(q + 2 * qs, ql));
        PA_IDS(t2);
        float part[16];
#pragma unroll
        for (int k = 0; k < 16; ++k) {
            const unsigned ww[4] = {ur[k].x, ur[k].y, ur[k].z, ur[k].w};
            f32x2 p2 = {0.f, 0.f};
#pragma unroll
            for (int wd = 0; wd < 4; ++wd) { p2 = __builtin_elementwise_fma(fp8x2_lo(ww[wd]), (f32x2){hv[wd][0], hv[wd][1]}, p2); p2 = __builtin_elementwise_fma(fp8x2_hi(ww[wd]), (f32x2){hv[wd][2], hv[wd][3]}, p2); }
            part[k] = p2[0] + p2[1];
        }
        float w8[8], w4[4], w2[2];
        { const bool up = (lane & 4) != 0;
#pragma unroll
          for (int m = 0; m < 8; ++m) { const float keep = up ? part[m + 8] : part[m], send = up ? part[m] : part[m + 8]; w8[m] = keep + xor4_f(send); } }
        { const bool up = (lane & 2) != 0;
#pragma unroll
          for (int m = 0; m < 4; ++m) { const float keep = up ? w8[m + 4] : w8[m], send = up ? w8[m] : w8[m + 4]; w4[m] = keep + dpp_f<0x4E>(send); } }
        { const bool up = (lane & 1) != 0;
#pragma unroll
          for (int m = 0; m < 2; ++m) { const float keep = up ? w4[m + 2] : w4[m], send = up ? w4[m] : w4[m + 2]; w2[m] = keep + dpp_f<0xB1>(send); } }
        *(f32x2*)(PD + (size_t)t * 1024) = (f32x2){w2[0], w2[1]};
        if (q + qs > ql) break;
#pragma unroll
        for (int k = 0; k < 16; ++k) ur[k] = urn[k];
#pragma unroll
        for (int qq = 0; qq < 4; ++qq) hv[qq] = hn[qq];
        t = t1; t1 = t2;
    }
#undef PA_LD
#undef PA_IDS
#undef PA_GATHER
}

__device__ __forceinline__ void peer_coef(const Args& a, const int widx, const int nwtot, const int row_lo, const int row_hi) {
    const int lane = threadIdx.x & 63, half = lane >> 5, l5 = lane & 31;
    unsigned char* ws = a.ws;
    const f32x2* SC = (const f32x2*)(ws + WS_USC); const float* rowss = (const float*)(ws + WS_ROWSS);
    for (int row = row_lo + widx; row < row_hi; row += nwtot) {
        const unsigned* kp = (const unsigned*)(ws + WS_PEERK) + (size_t)row * 256 + 4 * l5;
        const float* pd = (const float*)(ws + WS_PD) + (size_t)row * 1024 + half * 512 + 4 * l5;
        const u32x4 ids = *(const u32x4*)kp;
        const f32x4 g = *(const f32x4*)(kp + 128);
        f32x4 d = *(const f32x4*)pd;
#pragma unroll
        for (int sl = 1; sl < 4; ++sl) d = d + *(const f32x4*)(pd + sl * 128);
        const f32x2 s0 = SC[ids.x], s1 = SC[ids.y], s2 = SC[ids.z], s3 = SC[ids.w];
        const float rs2 = rsqrtf(rowss[row] * (1.0f / DM) + EPS);
#pragma unroll
        for (int c = 0; c < 4; ++c) d[c] += __shfl_xor(d[c], 32);
        f32x4 cf;
        cf[0] = g[0] * gelu_erf(d[0] * rs2 * s0[0]) * s0[1]; cf[1] = g[1] * gelu_erf(d[1] * rs2 * s1[0]) * s1[1];
        cf[2] = g[2] * gelu_erf(d[2] * rs2 * s2[0]) * s2[1]; cf[3] = g[3] * gelu_erf(d[3] * rs2 * s3[0]) * s3[1];
        if (half == 0) *(f32x4*)((float*)(ws + WS_COEF) + (size_t)row * 128 + 4 * l5) = cf;
    }
}

template <bool NT>
__device__ __forceinline__ void peer_passB(const Args& a, const PeerWork w) {
    const int lane = threadIdx.x & 63;
    const int j = w.j, r = lane >> 3, sub = lane & 7;
    unsigned char* ws = a.ws;
    const unsigned char* Vs = ws + WS_V8 + (size_t)j * SLICE_BYTES; const unsigned sub16 = 16u * (unsigned)sub;
    const unsigned* KP = (const unsigned*)(ws + WS_PEERK) + 16 * r;
    const float* CO = (const float*)(ws + WS_COEF) + 16 * r;
    const float* H = (const float*)(ws + WS_H) + 128 * j + 16 * sub + 2 * r;
    float* Y = a.out + 128 * j + 16 * sub + 2 * r;
    const int qs = w.qstep, ql = w.nq - 1;
    int q = w.q0;
    if (q > ql) return;
    u32x4 idv[4], vr[16]; f32x4 cf[4]; f32x2 hv;
#define PB_LD(P) (NT ? __builtin_nontemporal_load((const u32x4*)(P)) : *(const u32x4*)(P))
#define PB_IDS(T) do { const unsigned* kp_ = KP + (size_t)(T) * 256; _Pragma("unroll") for (int qq = 0; qq < 4; ++qq) idv[qq] = *(const u32x4*)(kp_ + 4 * qq); } while (0)
#define PB_GATHER(T, VR, CF, HV) do { _Pragma("unroll") for (int qq = 0; qq < 4; ++qq) { VR[4 * qq] = PB_LD(Vs + (idv[qq].x * 128u + sub16)); VR[4 * qq + 1] = PB_LD(Vs + (idv[qq].y * 128u + sub16)); \
            VR[4 * qq + 2] = PB_LD(Vs + (idv[qq].z * 128u + sub16)); VR[4 * qq + 3] = PB_LD(Vs + (idv[qq].w * 128u + sub16)); } \
        const float* cp_ = CO + (size_t)(T) * 128; _Pragma("unroll") for (int qq = 0; qq < 4; ++qq) CF[qq] = *(const f32x4*)(cp_ + 4 * qq); \
        HV = *(const f32x2*)(H + (size_t)(T) * DM); } while (0)
    int t = peer_tok(w, q), t1 = peer_tok(w, min(q + qs, ql));
    PB_IDS(t);
    PB_GATHER(t, vr, cf, hv);
    PB_IDS(t1);
#pragma unroll 1
    for (;; q += qs) {
        u32x4 vrn[16]; f32x4 cfn[4]; f32x2 hn;
        PB_GATHER(t1, vrn, cfn, hn);
        const int t2 = peer_tok(w, min(q + 2 * qs, ql));
        PB_IDS(t2);
        f32x2 acc[8];
#pragma unroll
        for (int m = 0; m < 8; ++m) acc[m] = (f32x2){0.f, 0.f};
#pragma unroll
        for (int k = 0; k < 16; ++k) {
            const unsigned ww[4] = {vr[k].x, vr[k].y, vr[k].z, vr[k].w};
            const float c = cf[k >> 2][k & 3]; const f32x2 c2 = {c, c};
#pragma unroll
            for (int wd = 0; wd < 4; ++wd) { acc[2 * wd] = __builtin_elementwise_fma(fp8x2_lo(ww[wd]), c2, acc[2 * wd]); acc[2 * wd + 1] = __builtin_elementwise_fma(fp8x2_hi(ww[wd]), c2, acc[2 * wd + 1]); }
        }
        float w8[8], w4[4], w2[2];
#pragma unroll
        for (int m = 0; m < 8; ++m) { const auto sw = __builtin_amdgcn_permlane32_swap(__float_as_uint(acc[m >> 1][m & 1]), __float_as_uint(acc[(m + 8) >> 1][m & 1]), false, false); w8[m] = __uint_as_float(sw[0]) + __uint_as_float(sw[1]); }
#pragma unroll
        for (int m = 0; m < 4; ++m) { const auto sw = __builtin_amdgcn_permlane16_swap(__float_as_uint(w8[m]), __float_as_uint(w8[m + 4]), false, false); w4[m] = __uint_as_float(sw[0]) + __uint_as_float(sw[1]); }
        { const bool up = (lane & 8) != 0;
#pragma unroll
          for (int m = 0; m < 2; ++m) { const float keep = up ? w4[m + 2] : w4[m], send = up ? w4[m] : w4[m + 2]; w2[m] = keep + dpp_f<0x128>(send); } }
        *(f32x2*)(Y + (size_t)t * DM) = (f32x2){hv[0] + w2[0], hv[1] + w2[1]};
        if (q + qs > ql) break;
#pragma unroll
        for (int k = 0; k < 16; ++k) vr[k] = vrn[k];
#pragma unroll
        for (int qq = 0; qq < 4; ++qq) cf[qq] = cfn[qq];
        hv = hn;
        t = t1; t1 = t2;
    }
#undef PB_LD
#undef PB_IDS
#undef PB_GATHER
}

__device__ __forceinline__ void stream_task(const Args& a, const int task, const int wave, const float kbA, LAS unsigned* rb, unsigned& ep) {
    const int lane = threadIdx.x & 63;
    unsigned char* ws = a.ws; float* out = a.out;
    const bf16_t* QA = (const bf16_t*)(ws + WS_QA); bf16_t* CAT = (bf16_t*)(ws + WS_CAT);
    {
            const int b = task >> 1, hh = task & 1, hd = 4 * hh + (lane >> 4), dl = 4 * (lane & 15);
            const float slope2 = alibi_slope(hd) * LOG2E;
            f32x4 q[8], O[8]; float M[8], l[8];
#pragma unroll
            for (int i = 0; i < 8; ++i) {
                const u32x2 qr = *(const u32x2*)(QA + (size_t)(NTP + b * DS + i) * 512 + hd * 64 + dl);
                q[i] = (f32x4){bf_lo(qr.x), bf_hi(qr.x), bf_lo(qr.y), bf_hi(qr.y)};
                M[i] = sqrtf(row_sum_f(q[i][0] * q[i][0] + q[i][1] * q[i][1] + q[i][2] * q[i][2] + q[i][3] * q[i][3])) * kbA;
                O[i] = (f32x4){0.f, 0.f, 0.f, 0.f}; l[i] = 0.f;
            }
            const f32x4 qa = wave == 0 ? q[0] : wave == 1 ? q[1] : wave == 2 ? q[2] : q[3], qb = wave == 0 ? q[4] : wave == 1 ? q[5] : wave == 2 ? q[6] : q[7];
            const float Ma = wave == 0 ? M[0] : wave == 1 ? M[1] : wave == 2 ? M[2] : M[3], Mb = wave == 0 ? M[4] : wave == 1 ? M[5] : wave == 2 ? M[6] : M[7];
            f32x4 Oa = {0.f, 0.f, 0.f, 0.f}, Ob = {0.f, 0.f, 0.f, 0.f}; float la = 0.f, lb = 0.f;
            const size_t co = ((size_t)b * LA * 8 + hd) * 64 + dl;
            const float* kc = a.in[2] + co; const float* vc = a.in[3] + co; float* ko = out + O_AKS + co; float* vo = out + O_AVS + co;
            constexpr int NGRP = 480 / SB;
            int gq = 0;
            f32x4 k4[SB], v4[SB];
#pragma unroll
            for (int u = 0; u < SB; ++u) { const size_t ro = (size_t)(wave + 4 * (SB * gq + u)) * 512; k4[u] = __builtin_nontemporal_load((const f32x4*)(kc + ro)); v4[u] = __builtin_nontemporal_load((const f32x4*)(vc + ro)); }
#pragma unroll 1
            for (int it = 0; it < NGRP; ++it) {
                const int n0 = SB * gq;
                gq = gq + 1 == NGRP ? 0 : gq + 1;
                f32x4 kn4[SB], vn4[SB];
#pragma unroll
                for (int u = 0; u < SB; ++u) { const size_t ro = (size_t)(wave + 4 * (SB * gq + u)) * 512; kn4[u] = __builtin_nontemporal_load((const f32x4*)(kc + ro)); vn4[u] = __builtin_nontemporal_load((const f32x4*)(vc + ro)); }
#pragma unroll
                for (int u = 0; u < SB; ++u) {
                    const int n = n0 + u;
                    if (n >= 2) { const size_t wo = (size_t)(wave + 4 * n - DS) * 512; __builtin_nontemporal_store(k4[u], (f32x4*)(ko + wo)); __builtin_nontemporal_store(v4[u], (f32x4*)(vo + wo)); }
                    const int da = LA - 4 * n, db = da + 4;
                    const int ma = (da <= 512 ? 1 : 0) + ((da & 15) == 0 ? 1 : 0), mb = (db <= 512 ? 1 : 0) + ((db & 15) == 0 ? 1 : 0);
                    if (ma) {
                        const float dot = row_sum_f(qa[0] * k4[u][0] + qa[1] * k4[u][1] + qa[2] * k4[u][2] + qa[3] * k4[u][3]);
                        const float pp = __builtin_amdgcn_exp2f(dot - slope2 * (float)da - Ma) * (float)ma;
                        la += pp; Oa = Oa + v4[u] * pp;
                    }
                    if (mb) {
                        const float dot = row_sum_f(qb[0] * k4[u][0] + qb[1] * k4[u][1] + qb[2] * k4[u][2] + qb[3] * k4[u][3]);
                        const float pp = __builtin_amdgcn_exp2f(dot - slope2 * (float)db - Mb) * (float)mb;
                        lb += pp; Ob = Ob + v4[u] * pp;
                    }
                }
#pragma unroll
                for (int u = 0; u < SB; ++u) { k4[u] = kn4[u]; v4[u] = vn4[u]; }
            }
#pragma unroll 1
            for (int n0 = 480; n0 < 512; n0 += 4) {
                f32x4 k4[4], v4[4];
#pragma unroll
                for (int u = 0; u < 4; ++u) { const size_t ro = (size_t)(wave + 4 * (n0 + u)) * 512; k4[u] = __builtin_nontemporal_load((const f32x4*)(kc + ro)); v4[u] = __builtin_nontemporal_load((const f32x4*)(vc + ro)); }
#pragma unroll
                for (int u = 0; u < 4; ++u) {
                    const int r = wave + 4 * (n0 + u);
                    { const size_t wo = (size_t)(r - DS) * 512; __builtin_nontemporal_store(k4[u], (f32x4*)(ko + wo)); __builtin_nontemporal_store(v4[u], (f32x4*)(vo + wo)); }
#pragma unroll
                    for (int i = 0; i < 8; ++i) {
                        const int dist = LA + i - r;
                        const int mult = (dist <= 128 ? 1 : 0) + ((dist & 3) == 0 ? 1 : 0) + ((dist & 15) == 0 ? 1 : 0);
                        if (mult) {
                            const float dot = row_sum_f(q[i][0] * k4[u][0] + q[i][1] * k4[u][1] + q[i][2] * k4[u][2] + q[i][3] * k4[u][3]);
                            const float pp = __builtin_amdgcn_exp2f(dot - slope2 * (float)dist - M[i]) * (float)mult;
                            l[i] += pp; O[i] = O[i] + v4[u] * pp;
                        }
                    }
                }
            }
#pragma unroll
            for (int nn = 0; nn < 2; ++nn) {
                const int nr = wave + 4 * nn;
                const size_t no = (size_t)(LA - DS + nr) * 512;
                const f32x4 kn = *(const f32x4*)(ko + no), vn = *(const f32x4*)(vo + no);
#pragma unroll
                for (int i = 0; i < 8; ++i) {
                    const int dist = i - nr;
                    if (dist >= 0) {
                        const int mult = 1 + ((dist & 3) == 0 ? 1 : 0) + (dist == 0 ? 1 : 0);
                        const float dot = row_sum_f(q[i][0] * kn[0] + q[i][1] * kn[1] + q[i][2] * kn[2] + q[i][3] * kn[3]);
                        const float pp = __builtin_amdgcn_exp2f(dot - slope2 * (float)dist - M[i]) * (float)mult;
                        l[i] += pp; O[i] = O[i] + vn * pp;
                    }
                }
            }
#pragma unroll
            for (int i = 0; i < 4; ++i) if (i == wave) { O[i] = O[i] + Oa; l[i] += la; O[i + 4] = O[i + 4] + Ob; l[i + 4] += lb; }
            f32x4* PO = (f32x4*)(ws + WS_SPART + (size_t)task * 40960);
            float* PL = (float*)(ws + WS_SPART + (size_t)task * 40960 + 32768);
#pragma unroll
            for (int i = 0; i < 8; ++i) { PO[(wave * 8 + i) * 64 + lane] = O[i]; PL[(wave * 8 + i) * 64 + lane] = l[i]; }
            bar4(rb, ep);
#pragma unroll
            for (int nn = 0; nn < 2; ++nn) {
                const int i = wave + 4 * nn;
                f32x4 Os = {0.f, 0.f, 0.f, 0.f}; float ls = 0.f;
#pragma unroll
                for (int w2 = 0; w2 < 4; ++w2) { Os = Os + __builtin_nontemporal_load(PO + (w2 * 8 + i) * 64 + lane); ls += __builtin_nontemporal_load(PL + (w2 * 8 + i) * 64 + lane); }
                const float inv = 1.0f / ls;
                u32x2 wv; wv.x = cvt_pk_bf16(Os[0] * inv, Os[1] * inv); wv.y = cvt_pk_bf16(Os[2] * inv, Os[3] * inv);
                *(u32x2*)(CAT + (size_t)(NTP + b * DS + i) * DM + hd * 64 + dl) = wv;
            }
    }
}

#define XB_PB(k) (32 * (k))
__device__ __forceinline__ void peer_barrier(unsigned* bar, const int k, const unsigned expected) {
    asm volatile("s_waitcnt vmcnt(0)" ::: "memory");
    __syncthreads();
    if (threadIdx.x == 0) {
        __builtin_amdgcn_fence(__ATOMIC_RELEASE, "agent");
        asm volatile("s_waitcnt vmcnt(0)" ::: "memory");
        (void)xb_add(&bar[XB_PB(k)], 1u);
        XB_SPIN(xb_ld(&bar[XB_PB(k)]) < expected, bar);
        __builtin_amdgcn_fence(__ATOMIC_ACQUIRE, "agent");
        asm volatile("s_waitcnt vmcnt(0)" ::: "memory");
    }
    __syncthreads();
}
__device__ __forceinline__ void p5a_stream_select(const Args& a, LAS unsigned char* lds) {
    const int tid = threadIdx.x, lane = tid & 63, wave = __builtin_amdgcn_readfirstlane(tid >> 6), G = gridDim.x, bid = blockIdx.x;
    LAS unsigned* rb = (LAS unsigned*)(lds + LDS_BARW - 16);
    if (tid < 2) rb[tid] = 0u;
    __syncthreads();
    if (wave < 4) {
        const float kbA = wave_max(fabsf(a.in[9][lane])) * 8.0f * 1.01f;
        unsigned ep = 0u;
        for (int task = bid; task < DB * 2; task += G) stream_task(a, task, wave, kbA, rb, ep);
    } else {
        peer_topk(a, lds, 4, 4, 0, NTP);
        sample_mixer_b(a, 4, 4);
    }
    __syncthreads();
}
__global__ void __launch_bounds__(NTHREADS, 2) fwd_kernel(Args args) {
    extern __shared__ __attribute__((aligned(16))) unsigned char lds_raw[];
    LAS unsigned char* lds = (LAS unsigned char*)lds_raw;
    const int tid = threadIdx.x;
    if (tid < 8) ((LAS unsigned*)(lds + LDS_BARW - 16))[tid] = 0u;
    __syncthreads();
    const int lo = args.ph_lo, hi = args.ph_hi;
    const bool one = (hi - lo) > 1;
    XcdBarrier bar; bar.bar = (unsigned*)(args.ws + WS_BAR); bar.x = 0; bar.st = nullptr;
    if (one) bar = xcd_barrier_post((unsigned*)(args.ws + WS_BAR), (volatile LAS unsigned*)(lds + LDS_BARW));
#ifndef PH_MASK
#define PH_MASK 2047
#endif
#define IN(k) (((PH_MASK >> (k)) & 1) && lo <= (k) && (k) < hi)
#define SEAM(k) do { if (IN(k) && IN((k) + 1)) xcd_barrier(bar); } while (0)
    unsigned char* ws = args.ws;
    if (IN(0)) p0_prologue(args, lds);
    SEAM(0);
    if (IN(1)) {
        const int G = (int)gridDim.x, GP = (CONV_IN_P1 && G == 256) ? 208 : G;
        if ((int)blockIdx.x < GP) {
            pg8::Gemm g{(const bf16_t*)(ws + WS_XB), (const bf16_t*)(ws + WS_BT1), MT, NQKV, DM}; pg8::StaticOrder S; S.init(MT, NQKV, GP, (int)blockIdx.x);
            EpiQKV E{(const float*)(ws + WS_RSTD1), args.in[8], args.in[9], args.in[10], args.in[11],
                     (bf16_t*)(ws + WS_QA), (bf16_t*)(ws + WS_KA), (bf16_t*)(ws + WS_VAT), (bf16_t*)(ws + WS_QB), (bf16_t*)(ws + WS_KB), (bf16_t*)(ws + WS_VBT), args.out};
            pg8::gemm_phase<EpiQKV, pg8::StaticOrder, true, true>(lds, g, S, E);
        } else tables_fp8(args, ((int)blockIdx.x - GP) * NWAVES + __builtin_amdgcn_readfirstlane(threadIdx.x >> 6), (G - GP) * NWAVES);
    }
    SEAM(1);
    if (IN(2)) p2_attention(args, lds);
    SEAM(2);
#define GEMM_H(ROW0, MROWS, GG, CC) do { pg8::Gemm g{(const bf16_t*)(ws + WS_CAT) + (size_t)(ROW0) * DM, (const bf16_t*)(ws + WS_BT2), (MROWS), DM, DM}; pg8::StaticOrder S; S.init((MROWS), DM, (GG), (CC)); \
        EpiH E{args.in[0], args.in[1], (float*)(ws + WS_H), (bf16_t*)(ws + WS_HB), (float*)(ws + WS_ROWSS), (ROW0)}; \
        pg8::gemm_phase<EpiH, pg8::StaticOrder, true, true>(lds, g, S, E); } while (0)
#define GEMM_S(ROW0, MROWS, GG, CC) do { pg8::Gemm g{(const bf16_t*)(ws + WS_HB) + (size_t)(ROW0) * DM, (const bf16_t*)(ws + WS_BT3), (MROWS), NPQ, DM}; pg8::StaticOrder S; S.init((MROWS), NPQ, (GG), (CC)); \
        EpiS E{(const float*)(ws + WS_ROWSS), (float*)(ws + WS_S), (ROW0)}; \
        pg8::gemm_phase<EpiS, pg8::StaticOrder, true, true>(lds, g, S, E); } while (0)
    if (IN(3)) GEMM_H(0, NTP, (int)gridDim.x, (int)blockIdx.x);
    SEAM(3);
    if (IN(4)) GEMM_S(0, NTP, (int)gridDim.x, (int)blockIdx.x);
    SEAM(4);
    if (IN(5)) p5a_stream_select(args, lds);
    SEAM(5);
    const int wv = __builtin_amdgcn_readfirstlane(threadIdx.x >> 6), NI = (int)gridDim.x >> 3;
    if (IN(6)) {
        constexpr int ND = 2;
        const int cc = (int)blockIdx.x - 8 * (NI - ND);
        if (cc < 0) peer_passA<false>(args, peer_work_plain(wv, NWAVES, NI - ND, 0, NTP));
        else {
            GEMM_H(NTP, NTS, 8 * ND, cc);
            peer_barrier((unsigned*)(ws + WS_BAR), 2, 8u * ND);
            GEMM_S(NTP, NTS, 8 * ND, cc);
        }
    }
    SEAM(6);
    if (IN(7)) { peer_coef(args, (int)blockIdx.x * NWAVES + wv, (int)gridDim.x * NWAVES, 0, NTP); peer_topk(args, lds, 0, NWAVES, NTP, MT); }
    SEAM(7);
    if (IN(8)) { peer_passB<false>(args, peer_work_plain(wv, NWAVES, NI, 0, NTP)); peer_passA<false>(args, peer_work_plain(wv, NWAVES, NI, NTP, MT)); }
    SEAM(8);
    if (IN(9)) peer_coef(args, (int)blockIdx.x * NWAVES + wv, (int)gridDim.x * NWAVES, NTP, MT);
    SEAM(9);
    if (IN(10)) peer_passB<false>(args, peer_work_plain(wv, NWAVES, NI, NTP, MT));

#undef IN
#undef SEAM
}

extern "C" void kernel_launch(void* const* d_in, const int* in_sizes, int n_in, void* d_out, int out_size, void* d_ws, size_t ws_size, hipStream_t stream) {
    static int grid = 0;
    if (grid == 0) {
        if (n_in != 19 || (size_t)out_size != O_END || ws_size < WS_END) { fprintf(stderr, "kernel_launch: unexpected shapes (n_in %d out %d ws %zu)\n", n_in, out_size, ws_size); grid = -1; return; }
        int dev = 0, cus = 0, per_cu = 0;
        if (hipGetDevice(&dev) != hipSuccess || hipDeviceGetAttribute(&cus, hipDeviceAttributeMultiprocessorCount, dev) != hipSuccess) { grid = -1; return; }
        if (hipFuncSetAttribute((const void*)fwd_kernel, hipFuncAttributeMaxDynamicSharedMemorySize, LDS_BYTES) != hipSuccess) { fprintf(stderr, "kernel_launch: hipFuncSetAttribute failed\n"); grid = -1; return; }
        if (hipOccupancyMaxActiveBlocksPerMultiprocessor(&per_cu, (const void*)fwd_kernel, NTHREADS, LDS_BYTES) != hipSuccess || per_cu < 1) { fprintf(stderr, "kernel_launch: occupancy query says %d\n", per_cu); }
        (void)hipGetLastError();
        if (cus < 32 || (cus & 7)) { fprintf(stderr, "kernel_launch: %d CUs\n", cus); grid = -1; return; }
        grid = cus;
    }
    if (grid < 0) return;
    (void)hipMemsetAsync((char*)d_ws + WS_BAR, 0, WS_ZERO_BYTES, stream);
    Args a{};
    for (int i = 0; i < 19; ++i) a.in[i] = (const float*)d_in[i];
    a.out = (float*)d_out; a.ws = (unsigned char*)d_ws;
#if N_LAUNCHES == 1
    a.ph_lo = 0; a.ph_hi = 11;
    hipLaunchKernelGGL(fwd_kernel, dim3(grid), dim3(NTHREADS), LDS_BYTES, stream, a);
#else
    for (int p = 0; p < 11; ++p) { a.ph_lo = p; a.ph_hi = p + 1; hipLaunchKernelGGL(fwd_kernel, dim3(grid), dim3(NTHREADS), LDS_BYTES, stream, a); }
#endif
}
```

```cpp
#include <hip/hip_runtime.h>
#include <cstdio>
#include <cstdint>

#ifndef PEER_SCALE
#define PEER_SCALE 1.0f
#endif
#ifndef SB
#define SB 4
#endif
#ifndef CONV_IN_P1
#define CONV_IN_P1 1
#endif
#ifndef N_LAUNCHES
#define N_LAUNCHES 1
#endif

namespace pg8 {
#define PG8_LAS __attribute__((address_space(3)))
typedef unsigned short bf16_t;
typedef short bf16x8 __attribute__((ext_vector_type(8)));
typedef float f32x4 __attribute__((ext_vector_type(4)));
typedef unsigned u32x4 __attribute__((ext_vector_type(4)));
constexpr int BM = 256, BK = 64, HALF = 128, HTB = HALF * BK * 2  , STAGE_BYTES = 8 * HTB, NXCD = 8, WGM = 8;

__host__ __device__ __forceinline__ int lds_byte(int r, int c) { const int st = (r >> 4) * 2 + (c >> 5), rr = r & 15, cc = c & 31, ob = rr * 64 + cc * 2; return st * 1024 + (ob ^ (((ob >> 9) & 1) << 5)); }
__host__ __device__ __forceinline__ void stage_rc(int b, int& R, int& C) { const int st = b / 1024, sb = b % 1024, swz = sb ^ (((sb >> 9) & 1) << 5); R = (st >> 1) * 16 + swz / 64; C = (st & 1) * 32 + (swz % 64) / 2; }
__host__ __device__ __forceinline__ int perm32(int rho) { const int n = rho >> 4, i = rho & 15; return 8 * (i >> 2) + 4 * n + (i & 3); }

struct Unit { int pm, pn; };
struct Gemm { const bf16_t* A; const bf16_t* Bt; int M, N, K; };

struct StaticOrder {
    int nM, nN, nwg, G, c;
    __host__ __device__ void init(int M, int N, int G_, int c_) { nM = M / BM; nN = N / BM; nwg = nM * nN; G = G_; c = c_; }
    __host__ __device__ bool next(int i, Unit& u) const {
        const long L = (long)i * G + c; if (L >= nwg) return false;
        int wgid = (int)L; { const int q = nwg / NXCD, r = nwg % NXCD, xcd = wgid % NXCD, off = wgid / NXCD; wgid = (xcd < r ? xcd * (q + 1) : r * (q + 1) + (xcd - r) * q) + off; }
        const int nig = WGM * nN, gid = wgid / nig, fm = gid * WGM, gsz = (nM - fm) < WGM ? (nM - fm) : WGM;
        u.pm = fm + ((wgid % nig) % gsz); u.pn = (wgid % nig) / gsz; return true;
    }

    __device__ __forceinline__ void a_ready(const Unit&) const {}
    __device__ __forceinline__ void done(const Unit&) const {}
};
__device__ __forceinline__ unsigned cvt_pk_bf16(float lo, float hi) { unsigned r; asm volatile("v_cvt_pk_bf16_f32 %0, %1, %2" : "=v"(r) : "v"(lo), "v"(hi)); return r; }
template <class Epi, class Sched, bool ALIGN_EPI = false, bool SP2 = false>
__device__ __forceinline__ void gemm_phase(PG8_LAS unsigned char* lds, const Gemm g, const Sched& S, const Epi& E) {
    const int tid = threadIdx.x, wid = __builtin_amdgcn_readfirstlane(tid >> 6), lane = tid & 63, wr = wid >> 2, wc = wid & 3, fr = lane & 15, fq = lane >> 4;
    const int K = g.K, nt = K / BK;
    unsigned voffA[2], voffB[2];
#pragma unroll
    for (int i = 0; i < 2; ++i) { int R, C; stage_rc(tid * 16 + i * 8192, R, C); const int Rb = Epi::PERM ? ((R & ~31) + perm32(R & 31)) : R;
        voffA[i] = (unsigned)(R * K + C) * 2u; voffB[i] = (unsigned)(Rb * K + C) * 2u; }
    const size_t kstep = (size_t)(BK * 2);
    const size_t hstep = (size_t)HALF * K * 2;
    const size_t tstep = 2 * hstep;
    const unsigned ldsw = (unsigned)wid * 1024u;
    const int aoff = lds_byte(wr * 64 + fr, fq * 8), boff = lds_byte(wc * 32 + fr, fq * 8);
#define PG8_SA(b, h) (((b) * 2 + (h)) * HTB)
#define PG8_SB(b, h) ((4 + (b) * 2 + (h)) * HTB)
#define PG8_STAGE(bufoff, gbase, voff) do { _Pragma("unroll") for (int _i = 0; _i < 2; ++_i) \
        __builtin_amdgcn_global_load_lds((const unsigned*)((const char*)(gbase) + (voff)[_i]), (PG8_LAS unsigned*)(lds + (bufoff) + ldsw + _i * 8192), 16, 0, 0); } while (0)
#define PG8_LDA(dst, b, h) do { _Pragma("unroll") for (int m = 0; m < 4; ++m) _Pragma("unroll") for (int k = 0; k < 2; ++k) dst[m][k] = *(const PG8_LAS bf16x8*)(lds + PG8_SA(b, h) + aoff + m * 2048 + k * 1024); } while (0)
#define PG8_LDB(dst, b, h) do { _Pragma("unroll") for (int n = 0; n < 2; ++n) _Pragma("unroll") for (int k = 0; k < 2; ++k) dst[n][k] = *(const PG8_LAS bf16x8*)(lds + PG8_SB(b, h) + boff + n * 2048 + k * 1024); } while (0)
#define PG8_MMA(ai, bj, At, Bt) do { __builtin_amdgcn_s_setprio(1); _Pragma("unroll") for (int m = 0; m < 4; ++m) _Pragma("unroll") for (int n = 0; n < 2; ++n) _Pragma("unroll") for (int k = 0; k < 2; ++k) \
        acc[ai][bj][m][n] = __builtin_amdgcn_mfma_f32_16x16x32_bf16(Bt[n][k], At[m][k], acc[ai][bj][m][n], 0, 0, 0); __builtin_amdgcn_s_setprio(0); } while (0)
#define PG8_WAIT_V(n) asm volatile("s_waitcnt vmcnt(" #n ")" ::: "memory")
#define PG8_WAIT_L(n) asm volatile("s_waitcnt lgkmcnt(" #n ")" ::: "memory")
#define PG8_BAR __builtin_amdgcn_s_barrier()
#define PG8_SCHED __builtin_amdgcn_sched_barrier(0)
    Unit cur, nxt; int ui = 0;
    if (!S.next(0, cur)) return;
    f32x4 acc[2][2][4][2];
    if constexpr (Epi::INIT_ACC) E.init(acc, cur, wr, wc, fr, fq);
    else {
#pragma unroll
    for (int a = 0; a < 2; ++a)
#pragma unroll
        for (int b = 0; b < 2; ++b)
#pragma unroll
            for (int m = 0; m < 4; ++m)
#pragma unroll
                for (int n = 0; n < 2; ++n) acc[a][b][m][n] = (f32x4){0.f, 0.f, 0.f, 0.f};
    }
    bf16x8 At[4][2], B0[2][2], B1[2][2];
    const char* cA = (const char*)g.A + (size_t)cur.pm * tstep; const char* cB = (const char*)g.Bt + (size_t)cur.pn * tstep;
    S.a_ready(cur);
    if constexpr (SP2) {
        PG8_STAGE(PG8_SB(0, 0), cB, voffB); PG8_STAGE(PG8_SB(0, 1), cB + hstep, voffB); PG8_STAGE(PG8_SA(0, 0), cA, voffA); PG8_STAGE(PG8_SA(0, 1), cA + hstep, voffA);
        if (wr == 1) PG8_BAR;
        PG8_WAIT_V(2); PG8_BAR;
        PG8_STAGE(PG8_SB(1, 0), cB + kstep, voffB); PG8_STAGE(PG8_SA(1, 0), cA + kstep, voffA); PG8_STAGE(PG8_SB(1, 1), cB + hstep + kstep, voffB);
        PG8_WAIT_V(6); PG8_BAR;
    } else {
        PG8_STAGE(PG8_SB(0, 0), cB, voffB); PG8_STAGE(PG8_SA(0, 0), cA, voffA); PG8_STAGE(PG8_SB(0, 1), cB + hstep, voffB); PG8_STAGE(PG8_SA(0, 1), cA + hstep, voffA);
        if (wr == 1) PG8_BAR;
        PG8_WAIT_V(4); PG8_BAR;
        PG8_STAGE(PG8_SB(1, 0), cB + kstep, voffB); PG8_STAGE(PG8_SA(1, 0), cA + kstep, voffA); PG8_STAGE(PG8_SB(1, 1), cB + hstep + kstep, voffB);
        PG8_WAIT_V(6); PG8_BAR;
    }
    for (;;) {
        const bool has_next = S.next(ui + 1, nxt);
        const char* nA = has_next ? (const char*)g.A + (size_t)nxt.pm * tstep : cA; const char* nB = has_next ? (const char*)g.Bt + (size_t)nxt.pn * tstep : cB;
        for (int t = 0; t < nt; t += 2) {
            const bool last = (t == nt - 2);
            const char* a1 = cA + (size_t)(t + 1) * kstep;
            const char* a2 = last ? nA : cA + (size_t)(t + 2) * kstep; const char* b2 = last ? nB : cB + (size_t)(t + 2) * kstep;
            const char* a3 = a2 + kstep; const char* b3 = b2 + kstep;
            if (last && has_next) S.a_ready(nxt);
            if constexpr (SP2) {
            PG8_LDB(B0, 0, 0); PG8_LDB(B1, 0, 1); PG8_SCHED; PG8_LDA(At, 0, 0); PG8_STAGE(PG8_SA(1, 1), a1 + hstep, voffA);
            PG8_WAIT_V(8); PG8_WAIT_L(0); PG8_BAR; PG8_MMA(0, 0, At, B0); PG8_MMA(0, 1, At, B1); PG8_BAR; PG8_SCHED;
            PG8_LDA(At, 0, 1); PG8_STAGE(PG8_SB(0, 0), b2, voffB); PG8_STAGE(PG8_SB(0, 1), b2 + hstep, voffB); PG8_STAGE(PG8_SA(0, 0), a2, voffA);
            PG8_WAIT_V(8); PG8_WAIT_L(0); PG8_BAR; PG8_MMA(1, 0, At, B0); PG8_MMA(1, 1, At, B1); PG8_BAR; PG8_SCHED;
            PG8_LDB(B0, 1, 0); PG8_LDB(B1, 1, 1); PG8_SCHED; PG8_LDA(At, 1, 0); PG8_STAGE(PG8_SA(0, 1), a2 + hstep, voffA);
            PG8_WAIT_V(8); PG8_WAIT_L(0); PG8_BAR; PG8_MMA(0, 0, At, B0); PG8_MMA(0, 1, At, B1); PG8_BAR; PG8_SCHED;
            PG8_LDA(At, 1, 1); PG8_STAGE(PG8_SB(1, 0), b3, voffB); PG8_STAGE(PG8_SB(1, 1), b3 + hstep, voffB); PG8_STAGE(PG8_SA(1, 0), a3, voffA);
            PG8_WAIT_V(8); PG8_WAIT_L(0); PG8_BAR; PG8_MMA(1, 0, At, B0); PG8_MMA(1, 1, At, B1); PG8_BAR; PG8_SCHED;
            } else {
            PG8_LDB(B0, 0, 0); PG8_SCHED; PG8_LDA(At, 0, 0); PG8_STAGE(PG8_SA(1, 1), a1 + hstep, voffA);
            PG8_WAIT_L(8); PG8_BAR; PG8_WAIT_L(0); PG8_MMA(0, 0, At, B0); PG8_BAR; PG8_SCHED;
            PG8_LDB(B1, 0, 1); PG8_STAGE(PG8_SB(0, 0), b2, voffB);
            PG8_BAR; PG8_WAIT_L(0); PG8_MMA(0, 1, At, B1); PG8_BAR;
            PG8_LDA(At, 0, 1); PG8_STAGE(PG8_SA(0, 0), a2, voffA);
            PG8_BAR; PG8_WAIT_L(0); PG8_MMA(1, 0, At, B0); PG8_BAR; PG8_SCHED;
            PG8_STAGE(PG8_SB(0, 1), b2 + hstep, voffB);
            PG8_WAIT_V(6); PG8_BAR; PG8_MMA(1, 1, At, B1); PG8_BAR;
            PG8_LDB(B0, 1, 0); PG8_SCHED; PG8_LDA(At, 1, 0); PG8_STAGE(PG8_SA(0, 1), a2 + hstep, voffA);
            PG8_WAIT_L(8); PG8_BAR; PG8_WAIT_L(0); PG8_MMA(0, 0, At, B0); PG8_BAR; PG8_SCHED;
            PG8_LDB(B1, 1, 1); PG8_STAGE(PG8_SB(1, 0), b3, voffB);
            PG8_BAR; PG8_WAIT_L(0); PG8_MMA(0, 1, At, B1); PG8_BAR;
            PG8_LDA(At, 1, 1); PG8_STAGE(PG8_SA(1, 0), a3, voffA);
            PG8_BAR; PG8_WAIT_L(0); PG8_MMA(1, 0, At, B0); PG8_BAR; PG8_SCHED;
            PG8_STAGE(PG8_SB(1, 1), b3 + hstep, voffB);
            PG8_WAIT_V(6); PG8_BAR; PG8_MMA(1, 1, At, B1); PG8_BAR;
            }
        }
        if constexpr (ALIGN_EPI) { if (wr == 0) PG8_BAR; }
        if constexpr (!Epi::AFTER_DRAIN) { E(acc, cur, wr, wc, fr, fq); S.done(cur); }
        if (!has_next) break;
        if constexpr (Epi::INIT_ACC) E.init(acc, nxt, wr, wc, fr, fq);
        else {
#pragma unroll
        for (int a = 0; a < 2; ++a)
#pragma unroll
            for (int b = 0; b < 2; ++b)
#pragma unroll
                for (int m = 0; m < 4; ++m)
#pragma unroll
                    for (int n = 0; n < 2; ++n) acc[a][b][m][n] = (f32x4){0.f, 0.f, 0.f, 0.f};
        }
        cur = nxt; cA = nA; cB = nB; ++ui;
        if constexpr (ALIGN_EPI) { if (wr == 1) PG8_BAR; }
    }
    PG8_WAIT_V(0);
    if constexpr (!ALIGN_EPI) { if (wr == 0) PG8_BAR; }
    PG8_BAR;
    if constexpr (Epi::AFTER_DRAIN) { E.fused(acc, cur, wr, wc, fr, fq, lds, wid, lane); S.done(cur); }
#undef PG8_SA
#undef PG8_SB
#undef PG8_STAGE
#undef PG8_LDA
#undef PG8_LDB
#undef PG8_MMA
#undef PG8_WAIT_V
#undef PG8_WAIT_L
#undef PG8_BAR
#undef PG8_SCHED
}
}

#define XB_TMO      128
#define XB_XCNT(j)  (256  + 64 * (j))
#define XB_XSUB(j)  (1280 + 64 * (j))
#define XB_XGEN(j)  (2304 + 64 * (j))
#define XB_TOP      3328
#define XB_TOPGEN   3392
#define XCD_BAR_WORDS 3456
#define XB_SPIN_CAP (1u << 18)
#define LAS __attribute__((address_space(3)))

__device__ __forceinline__ unsigned xb_ld(unsigned* p)              { return __hip_atomic_load(p, __ATOMIC_RELAXED, __HIP_MEMORY_SCOPE_AGENT); }
__device__ __forceinline__ unsigned xb_add(unsigned* p, unsigned v) { return __hip_atomic_fetch_add(p, v, __ATOMIC_RELAXED, __HIP_MEMORY_SCOPE_AGENT); }
__device__ __forceinline__ unsigned xb_xcc_id() { return (unsigned)__builtin_amdgcn_s_getreg((3 << 11) | 20) & 0xFu; }
#define XB_SPIN(cond, bar) do { unsigned _sp = 0; while (cond) { __builtin_amdgcn_s_sleep(1); \
    if ((++_sp & 255u) == 0u) { if (xb_ld(&(bar)[XB_TMO])) break; if (_sp > XB_SPIN_CAP) { atomicAdd(&(bar)[XB_TMO], 1u); break; } } } } while (0)

struct XcdBarrier {
    unsigned* bar; unsigned x;
    volatile LAS unsigned* st;
};

__device__ __forceinline__ XcdBarrier xcd_barrier_post(unsigned* bar, volatile LAS unsigned* st) {
    XcdBarrier b; b.bar = bar; b.x = xb_xcc_id(); b.st = st;
    if (threadIdx.x == 0) (void)xb_add(&bar[XB_XCNT(b.x)], 1u);
    return b;
}
__device__ __forceinline__ void xcd_barrier_complete(unsigned* bar, unsigned x, unsigned& nloc, unsigned& nx) {
    const unsigned G = gridDim.x * gridDim.y * gridDim.z;
    unsigned sum, cnt, mine, sp = 0u;
    for (;;) {
        sum = 0u; cnt = 0u; mine = 0u;
#pragma unroll
        for (unsigned j = 0; j < 16; ++j) { const unsigned c = xb_ld(&bar[XB_XCNT(j)]); sum += c; cnt += (c > 0u) ? 1u : 0u; mine = (j == x) ? c : mine; }
        if (sum == G) break;
        __builtin_amdgcn_s_sleep(1);
        if ((++sp & 255u) == 0u) { if (xb_ld(&bar[XB_TMO])) break; if (sp > XB_SPIN_CAP) { atomicAdd(&bar[XB_TMO], 1u); break; } }
    }
    nloc = mine > 0u ? mine : 1u; nx = cnt > 0u ? cnt : 1u;
}

__device__ __forceinline__ void xcd_barrier(const XcdBarrier& b) {
    asm volatile("s_waitcnt vmcnt(0)" ::: "memory");
    __syncthreads();
    if (threadIdx.x == 0) {
        unsigned* bar = b.bar;
        __builtin_amdgcn_s_waitcnt(0);
        unsigned nloc = b.st[0], nx = b.st[1];
        if (nloc == 0u) { xcd_barrier_complete(bar, b.x, nloc, nx); b.st[0] = nloc; b.st[1] = nx; }
        const unsigned old = xb_add(&bar[XB_XSUB(b.x)], 1u);
        const unsigned gen = old / nloc;
        if (old + 1u == (gen + 1u) * nloc) {
            __builtin_amdgcn_fence(__ATOMIC_RELEASE, "agent");
            asm volatile("s_waitcnt vmcnt(0)" ::: "memory");
            const unsigned og = xb_add(&bar[XB_TOP], 1u);
            const unsigned tg = og / nx;
            if (og + 1u == (tg + 1u) * nx) xb_add(&bar[XB_TOPGEN], 1u);
            else XB_SPIN(xb_ld(&bar[XB_TOPGEN]) == tg, bar);
            __builtin_amdgcn_fence(__ATOMIC_ACQUIRE, "agent");
            xb_add(&bar[XB_XGEN(b.x)], 1u);
            asm volatile("s_waitcnt vmcnt(0)" ::: "memory");
        } else {
            XB_SPIN(xb_ld(&bar[XB_XGEN(b.x)]) == gen, bar);
            __builtin_amdgcn_fence(__ATOMIC_ACQUIRE, "agent");
            asm volatile("s_waitcnt vmcnt(0)" ::: "memory");
        }
    }
    __syncthreads();
}

using pg8::bf16_t; using pg8::bf16x8; using pg8::f32x4; using pg8::u32x4; using pg8::cvt_pk_bf16;
typedef float f32x16 __attribute__((ext_vector_type(16)));
typedef unsigned u32x2 __attribute__((ext_vector_type(2)));

constexpr int DM = 1024, NB = 4, SEQ = 4096, NTP = NB * SEQ, DB = 128, DS = 8, NTS = DB * DS, MT = NTP + NTS;
constexpr int LA = 2048, LBW = 128, NQKV = 2304, NPQ = 2048, NEXP = 16384;
constexpr float EPS = 1e-6f, LOG2E = 1.4426950408889634f, QSCALE = 0.125f * LOG2E;
constexpr int NTHREADS = 512, NWAVES = 8;
constexpr int LDS_BYTES = 158720;
constexpr int LDS_BARW = LDS_BYTES - 16;

constexpr size_t O_YP = 0, O_YS = 16777216, O_AKP = 17825792, O_AVP = 22020096, O_BKP = 26214400, O_BVP = 26279936,
                 O_AKS = 26345472, O_AVS = 160563200, O_BKS = 294780928, O_BVS = 296878080, O_END = 298975232;

constexpr size_t WS_BAR = 0, WS_ROWSS = 16384, WS_ZERO_BYTES = WS_ROWSS + (size_t)MT * 4;
constexpr size_t WS_RSTD1 = WS_ZERO_BYTES;
constexpr size_t WS_XB  = WS_RSTD1 + (size_t)MT * 4;
constexpr size_t WS_BT1 = WS_XB + (size_t)MT * DM * 2;
constexpr size_t WS_BT2 = WS_BT1 + (size_t)NQKV * DM * 2;
constexpr size_t WS_BT3 = WS_BT2 + (size_t)DM * DM * 2;
constexpr size_t WS_U8  = WS_BT3 + (size_t)NPQ * DM * 2;
constexpr size_t WS_V8  = WS_U8 + (size_t)NEXP * DM;
constexpr size_t WS_USC = WS_V8 + (size_t)NEXP * DM;
constexpr size_t WS_VSC = WS_USC + (size_t)NEXP * 4;
constexpr size_t WS_QA  = WS_VSC + (size_t)NEXP * 4;
constexpr size_t WS_KA  = WS_QA + (size_t)MT * 512 * 2;
constexpr size_t WS_VAT = WS_KA + (size_t)MT * 512 * 2;
constexpr size_t WS_QB  = WS_VAT + (size_t)MT * 512 * 2;
constexpr size_t WS_KB  = WS_QB + (size_t)MT * 512 * 2;
constexpr size_t WS_VBT = WS_KB + (size_t)MT * 128 * 2;
constexpr size_t WS_CAT = WS_VBT + (size_t)MT * 128 * 2;
constexpr size_t WS_H   = WS_CAT + (size_t)MT * DM * 2;
constexpr size_t WS_HB  = WS_H + (size_t)MT * DM * 4;
constexpr size_t WS_S   = WS_HB + (size_t)MT * DM * 2;
constexpr size_t WS_SPART = WS_S + (size_t)MT * NPQ * 4;
constexpr size_t WS_PEERK = WS_SPART + (size_t)DB * 2 * 40960;
constexpr size_t WS_PD = WS_PEERK + (size_t)MT * 1024;
constexpr size_t WS_COEF = WS_PD + (size_t)MT * 4096;
constexpr size_t WS_END = WS_COEF + (size_t)MT * 512;
constexpr size_t SLICE_BYTES = (size_t)NEXP * 128;
static_assert(WS_RSTD1 % 256 == 0 && WS_XB % 256 == 0 && WS_BT1 % 256 == 0 && WS_S % 256 == 0 && WS_PEERK % 256 == 0 && WS_PD % 256 == 0 && WS_U8 % 256 == 0, "alignment");

struct Args { const float* in[19]; float* out; unsigned char* ws; int ph_lo, ph_hi; };

__device__ __forceinline__ float wave_sum(float v) {
#pragma unroll
    for (int o = 32; o >= 1; o >>= 1) v += __shfl_xor(v, o);
    return v;
}
__device__ __forceinline__ float wave_max(float v) {
#pragma unroll
    for (int o = 32; o >= 1; o >>= 1) v = fmaxf(v, __shfl_xor(v, o));
    return v;
}
__device__ __forceinline__ float readlane_f(float v, int l) { return __uint_as_float((unsigned)__builtin_amdgcn_readlane((int)__float_as_uint(v), l)); }
__device__ __forceinline__ float bf_lo(unsigned w) { return __uint_as_float(w << 16); }
__device__ __forceinline__ float bf_hi(unsigned w) { return __uint_as_float(w & 0xffff0000u); }
__device__ __forceinline__ float alibi_slope(int h) { return exp2f(-(float)(h + 1)); }

__device__ __forceinline__ void late_prologue(const Args& a, LAS unsigned char* lds, LAS unsigned* rbc, unsigned& ep, const int aw);
__device__ __forceinline__ void p0_prologue(const Args& a, LAS unsigned char* lds) {
    const int tid = threadIdx.x, lane = tid & 63, wave = tid >> 6, G = gridDim.x, bid = blockIdx.x;
    unsigned char* ws = a.ws;
    {
        bf16_t* XB = (bf16_t*)(ws + WS_XB); float* rstd = (float*)(ws + WS_RSTD1);
        const int NWX = (CONV_IN_P1 && G == 256) ? 4 : NWAVES;
        const int rstep = G * NWX;
        int row = bid * NWX + wave;
        if (wave < NWX) {
        f32x4 v[4];
        if (row < MT) { const float* x = row < NTP ? a.in[0] + (size_t)row * DM : a.in[1] + (size_t)(row - NTP) * DM;
#pragma unroll
            for (int k = 0; k < 4; ++k) v[k] = *(const f32x4*)(x + k * 256 + lane * 4); }
        for (; row < MT; row += rstep) {
            f32x4 vn[4];
            { const int rn = min(row + rstep, MT - 1); const float* x = rn < NTP ? a.in[0] + (size_t)rn * DM : a.in[1] + (size_t)(rn - NTP) * DM;
#pragma unroll
              for (int k = 0; k < 4; ++k) vn[k] = *(const f32x4*)(x + k * 256 + lane * 4); }
            float ss = 0.f;
#pragma unroll
            for (int k = 0; k < 4; ++k) ss += v[k][0] * v[k][0] + v[k][1] * v[k][1] + v[k][2] * v[k][2] + v[k][3] * v[k][3];
            ss = wave_sum(ss);
            if (lane == 0) rstd[row] = rsqrtf(ss * (1.0f / DM) + EPS);
#pragma unroll
            for (int k = 0; k < 4; ++k) { u32x2 w; w.x = cvt_pk_bf16(v[k][0], v[k][1]); w.y = cvt_pk_bf16(v[k][2], v[k][3]); *(u32x2*)(XB + (size_t)row * DM + k * 256 + lane * 4) = w; }
#pragma unroll
            for (int k = 0; k < 4; ++k) v[k] = vn[k];
        }
        } else { unsigned ep = 0u; late_prologue(a, lds, (LAS unsigned*)(lds + LDS_BARW - 16) + 1, ep, wave - 4); }
        __syncthreads();
    }
    {
        LAS float* T = (LAS float*)lds;
        bf16_t* BT1 = (bf16_t*)(ws + WS_BT1); bf16_t* BT2 = (bf16_t*)(ws + WS_BT2);
        const int nt1 = (NQKV / 64) * 16, nt2 = 0;
        for (int t = bid; t < nt1 + nt2; t += G) {
            const bool first = t < nt1; const int t2 = first ? t : t - nt1;
            const int ct = t2 >> 4, dt = t2 & 15;
            const float* W = first ? a.in[7] : a.in[13]; const int ldw = first ? NQKV : DM; bf16_t* BT = first ? BT1 : BT2;
            const int ty = tid >> 6, tx = tid & 63;
#pragma unroll
            for (int k = 0; k < 8; ++k) { const int dd = ty + 8 * k; float w = W[(size_t)(dt * 64 + dd) * ldw + ct * 64 + tx]; if (first) w *= a.in[6][dt * 64 + dd]; T[dd * 65 + tx] = w; }
            __syncthreads();
            const int cc = tid >> 3, dsg = tid & 7, c = ct * 64 + cc;
            const int memrow = first ? (c & ~255) + ((c & 63) >> 5) * 128 + ((c & 255) >> 6) * 32 + (c & 31) : c;
            u32x4 w; w.x = cvt_pk_bf16(T[(8 * dsg + 0) * 65 + cc], T[(8 * dsg + 1) * 65 + cc]); w.y = cvt_pk_bf16(T[(8 * dsg + 2) * 65 + cc], T[(8 * dsg + 3) * 65 + cc]);
            w.z = cvt_pk_bf16(T[(8 * dsg + 4) * 65 + cc], T[(8 * dsg + 5) * 65 + cc]); w.w = cvt_pk_bf16(T[(8 * dsg + 6) * 65 + cc], T[(8 * dsg + 7) * 65 + cc]);
            *(u32x4*)(BT + (size_t)memrow * DM + dt * 64 + 8 * dsg) = w;
            __syncthreads();
        }
    }
}

struct EpiQKV {
    static constexpr bool PERM = true, AFTER_DRAIN = false, INIT_ACC = false;
    const float* rstd; const float* gqa; const float* gka; const float* gqb; const float* gkb;
    bf16_t* QA; bf16_t* KA; bf16_t* VAT; bf16_t* QB; bf16_t* KB; bf16_t* VBT; float* out;
    __device__ __forceinline__ void operator()(const f32x4 (&acc)[2][2][4][2], const pg8::Unit& u, int wr, int wc, int fr, int fq) const {
        const int hd = u.pn * 4 + wc;
        const int type = hd < 8 ? 0 : hd < 16 ? 1 : hd < 24 ? 2 : hd < 32 ? 3 : hd < 34 ? 4 : 5;
        const int hl = type == 0 ? hd : type == 1 ? hd - 8 : type == 2 ? hd - 16 : type == 3 ? hd - 24 : type == 4 ? hd - 32 : hd - 34;
        const float* gv = type == 0 ? gqa : type == 1 ? gka : type == 3 ? gqb : type == 4 ? gkb : nullptr;
        const float qs = (type == 0 || type == 3) ? QSCALE : 1.0f;
        f32x4 gg[2][2];
#pragma unroll
        for (int bj = 0; bj < 2; ++bj)
#pragma unroll
            for (int n = 0; n < 2; ++n) gg[bj][n] = gv ? *(const f32x4*)(gv + 32 * bj + 8 * fq + 4 * n) : (f32x4){1.f, 1.f, 1.f, 1.f};
#pragma unroll
        for (int ai = 0; ai < 2; ++ai)
#pragma unroll
            for (int m = 0; m < 4; ++m) {
                const int row = u.pm * 256 + ai * 128 + wr * 64 + m * 16 + fr;
                const float rs = rstd[row];
                f32x4 v[2][2]; float ss = 0.f;
#pragma unroll
                for (int bj = 0; bj < 2; ++bj)
#pragma unroll
                    for (int n = 0; n < 2; ++n) { v[bj][n] = acc[ai][bj][m][n] * rs; ss += v[bj][n][0] * v[bj][n][0] + v[bj][n][1] * v[bj][n][1] + v[bj][n][2] * v[bj][n][2] + v[bj][n][3] * v[bj][n][3]; }
                if (gv) {
                    ss += __shfl_xor(ss, 16); ss += __shfl_xor(ss, 32);
                    const float rn = rsqrtf(ss * (1.0f / 64.0f) + EPS) * qs;
#pragma unroll
                    for (int bj = 0; bj < 2; ++bj)
#pragma unroll
                        for (int n = 0; n < 2; ++n) v[bj][n] = v[bj][n] * rn * gg[bj][n];
                }
                const bool samp = row >= NTP;
                const int b = samp ? (row - NTP) >> 3 : row >> 12, pos = samp ? (row - NTP) & 7 : row & 4095;
                u32x4 pk[2];
#pragma unroll
                for (int bj = 0; bj < 2; ++bj) { pk[bj].x = cvt_pk_bf16(v[bj][0][0], v[bj][0][1]); pk[bj].y = cvt_pk_bf16(v[bj][0][2], v[bj][0][3]); pk[bj].z = cvt_pk_bf16(v[bj][1][0], v[bj][1][1]); pk[bj].w = cvt_pk_bf16(v[bj][1][2], v[bj][1][3]); }
                if (type == 0 || type == 3) {
                    bf16_t* dst = (type == 0 ? QA : QB) + (size_t)row * 512 + hl * 64 + 8 * fq;
                    *(u32x4*)dst = pk[0]; *(u32x4*)(dst + 32) = pk[1];
                } else if (type == 1 || type == 4) {
                    bf16_t* dst = type == 1 ? KA + (size_t)row * 512 + hl * 64 + 8 * fq : KB + (size_t)row * 128 + hl * 64 + 8 * fq;
                    *(u32x4*)dst = pk[0]; *(u32x4*)(dst + 32) = pk[1];
                    float* fo = nullptr;
                    if (type == 1) { if (samp) fo = out + O_AKS + ((size_t)(b * LA + LA - DS + pos) * 8 + hl) * 64; else if (pos >= SEQ - LA) fo = out + O_AKP + ((size_t)(b * LA + pos - (SEQ - LA)) * 8 + hl) * 64; }
                    else { if (samp) fo = out + O_BKS + ((size_t)(b * LBW + LBW - DS + pos) * 2 + hl) * 64; else if (pos >= SEQ - LBW) fo = out + O_BKP + ((size_t)(b * LBW + pos - (SEQ - LBW)) * 2 + hl) * 64; }
                    if (fo) {
#pragma unroll
                        for (int bj = 0; bj < 2; ++bj)
#pragma unroll
                            for (int n = 0; n < 2; ++n) *(f32x4*)(fo + 32 * bj + 8 * fq + 4 * n) = v[bj][n];
                    }
                } else {
                    bf16_t* dst = type == 2 ? VAT + (size_t)row * 512 + hl * 64 + 8 * fq : VBT + (size_t)row * 128 + hl * 64 + 8 * fq;
                    *(u32x4*)dst = pk[0]; *(u32x4*)(dst + 32) = pk[1];
                    float* fo = nullptr;
                    if (type == 2) { if (samp) fo = out + O_AVS + ((size_t)(b * LA + LA - DS + pos) * 8 + hl) * 64; else if (pos >= SEQ - LA) fo = out + O_AVP + ((size_t)(b * LA + pos - (SEQ - LA)) * 8 + hl) * 64; }
                    else { if (samp) fo = out + O_BVS + ((size_t)(b * LBW + LBW - DS + pos) * 2 + hl) * 64; else if (pos >= SEQ - LBW) fo = out + O_BVP + ((size_t)(b * LBW + pos - (SEQ - LBW)) * 2 + hl) * 64; }
                    if (fo) {
#pragma unroll
                        for (int bj = 0; bj < 2; ++bj)
#pragma unroll
                            for (int n = 0; n < 2; ++n) *(f32x4*)(fo + 32 * bj + 8 * fq + 4 * n) = v[bj][n];
                    }
                }
            }
    }
};
struct EpiH {
    static constexpr bool PERM = false, AFTER_DRAIN = false, INIT_ACC = true;
    const float* x0; const float* x1; float* H; bf16_t* HB; float* rowss; int row0;
    __device__ __forceinline__ void init(f32x4 (&acc)[2][2][4][2], const pg8::Unit& u, int wr, int wc, int fr, int fq) const {
#pragma unroll
        for (int ai = 0; ai < 2; ++ai)
#pragma unroll
            for (int m = 0; m < 4; ++m) {
                const int row = row0 + u.pm * 256 + ai * 128 + wr * 64 + m * 16 + fr;
                const float* xr = row < NTP ? x0 + (size_t)row * DM : x1 + (size_t)(row - NTP) * DM;
#pragma unroll
                for (int bj = 0; bj < 2; ++bj)
#pragma unroll
                    for (int n = 0; n < 2; ++n) acc[ai][bj][m][n] = *(const f32x4*)(xr + u.pn * 256 + bj * 128 + wc * 32 + n * 16 + 4 * fq);
            }
    }
    __device__ __forceinline__ void operator()(const f32x4 (&acc)[2][2][4][2], const pg8::Unit& u, int wr, int wc, int fr, int fq) const {
#pragma unroll
        for (int ai = 0; ai < 2; ++ai)
#pragma unroll
            for (int m = 0; m < 4; ++m) {
                const int row = row0 + u.pm * 256 + ai * 128 + wr * 64 + m * 16 + fr;
                float ss = 0.f;
#pragma unroll
                for (int bj = 0; bj < 2; ++bj)
#pragma unroll
                    for (int n = 0; n < 2; ++n) {
                        const int col = u.pn * 256 + bj * 128 + wc * 32 + n * 16 + 4 * fq;
                        const f32x4 h = acc[ai][bj][m][n];
                        *(f32x4*)(H + (size_t)row * DM + col) = h;
                        u32x2 w; w.x = cvt_pk_bf16(h[0], h[1]); w.y = cvt_pk_bf16(h[2], h[3]);
                        *(u32x2*)(HB + (size_t)row * DM + col) = w;
                        ss += h[0] * h[0] + h[1] * h[1] + h[2] * h[2] + h[3] * h[3];
                    }
                ss += __shfl_xor(ss, 16); ss += __shfl_xor(ss, 32);
                if (fq == 0) atomicAdd(rowss + row, ss);
            }
    }
};
struct EpiS {
    static constexpr bool PERM = false, AFTER_DRAIN = false, INIT_ACC = false;
    const float* rowss; float* S; int row0;
    __device__ __forceinline__ void operator()(const f32x4 (&acc)[2][2][4][2], const pg8::Unit& u, int wr, int wc, int fr, int fq) const {
#pragma unroll
        for (int ai = 0; ai < 2; ++ai)
#pragma unroll
            for (int m = 0; m < 4; ++m) {
                const int row = row0 + u.pm * 256 + ai * 128 + wr * 64 + m * 16 + fr;
                const float rs = rsqrtf(rowss[row] * (1.0f / DM) + EPS);
#pragma unroll
                for (int bj = 0; bj < 2; ++bj)
#pragma unroll
                    for (int n = 0; n < 2; ++n) {
                        const int col = u.pn * 256 + bj * 128 + wc * 32 + n * 16 + 4 * fq;
                        *(f32x4*)(S + (size_t)row * NPQ + col) = acc[ai][bj][m][n] * rs;
                    }
            }
    }
};

template <int CTRL> __device__ __forceinline__ float dpp_f(float x) { return __uint_as_float((unsigned)__builtin_amdgcn_update_dpp(0, (int)__float_as_uint(x), CTRL, 0xf, 0xf, false)); }
template <int CTRL> __device__ __forceinline__ int dpp_i(int x) { return __builtin_amdgcn_update_dpp(0, x, CTRL, 0xf, 0xf, false); }
template <int GS> __device__ __forceinline__ int grp_sum_i(int v) { v += dpp_i<0xB1>(v); v += dpp_i<0x4E>(v); if (GS == 8) v += dpp_i<0x141>(v); return v; }
template <int GS> __device__ __forceinline__ float grp_max_f(float v) { v = fmaxf(v, dpp_f<0xB1>(v)); v = fmaxf(v, dpp_f<0x4E>(v)); if (GS == 8) v = fmaxf(v, dpp_f<0x141>(v)); return v; }
template <int GS> __device__ __forceinline__ float grp_min_f(float v) { v = fminf(v, dpp_f<0xB1>(v)); v = fminf(v, dpp_f<0x4E>(v)); if (GS == 8) v = fminf(v, dpp_f<0x141>(v)); return v; }
__device__ __forceinline__ float row_max_f(float v) { v = fmaxf(v, dpp_f<0x128>(v)); v = fmaxf(v, dpp_f<0x124>(v)); v = fmaxf(v, dpp_f<0x122>(v)); v = fmaxf(v, dpp_f<0x121>(v)); return v; }
__device__ __forceinline__ float row_sum_f(float v) { v += dpp_f<0x128>(v); v += dpp_f<0x124>(v); v += dpp_f<0x122>(v); v += dpp_f<0x121>(v); return v; }


struct WT { const bf16_t* q; size_t qstride; const bf16_t* k; const bf16_t* v; size_t kstride; int i0; float slope2; };
typedef short s16x4 __attribute__((ext_vector_type(4)));
__device__ __forceinline__ void attn_tile(const WT& w, float kbound, float mfloor, LAS unsigned char* stg, f32x16 (&O)[2], float& ltot, float& Mq) {
    const int lane = threadIdx.x & 63, tq = lane & 31, g = lane >> 5;
    bf16x8 qb[4];
    float qq = 0.f;
#pragma unroll
    for (int c = 0; c < 4; ++c) {
        const u32x4 raw = *(const u32x4*)(w.q + (size_t)tq * w.qstride + 16 * c + 8 * g);
        qb[c] = __builtin_bit_cast(bf16x8, raw);
        const unsigned ww[4] = {raw.x, raw.y, raw.z, raw.w};
#pragma unroll
        for (int e = 0; e < 4; ++e) { const float lo = bf_lo(ww[e]), hi = bf_hi(ww[e]); qq += lo * lo + hi * hi; }
    }
    qq += __shfl_xor(qq, 32);
    Mq = fmaxf(sqrtf(qq) * kbound, mfloor);
#pragma unroll
    for (int dt = 0; dt < 2; ++dt)
#pragma unroll
        for (int i = 0; i < 16; ++i) O[dt][i] = 0.f;
    float lsum = 0.f;
    const int jbase = w.i0 - 128;
    const int kap = (tq & ~12) | ((tq & 8) >> 1) | ((tq & 4) << 1);
#define ATT_LOAD(KT, KK, VV) do { const int j0_ = jbase + 32 * (KT); const int jk_ = max(j0_ + kap, 0); \
        _Pragma("unroll") for (int c = 0; c < 4; ++c) KK[c] = *(const bf16x8*)(w.k + (size_t)jk_ * w.kstride + 16 * c + 8 * g); \
        _Pragma("unroll") for (int t = 0; t < 2; ++t) { const int jv_ = max(j0_ + 16 * t + (lane >> 2), 0); const bf16_t* vp_ = w.v + (size_t)jv_ * w.kstride + 16 * (lane & 3); VV[t][0] = *(const u32x4*)vp_; VV[t][1] = *(const u32x4*)(vp_ + 8); } } while (0)
    const int kt0 = max(0, (128 - w.i0) >> 5);
    bf16x8 ka[4]; u32x4 vv[2][2];
    ATT_LOAD(kt0, ka, vv);
#pragma unroll 1
    for (int kt = kt0; kt < 5; ++kt) {
        const int j0 = jbase + 32 * kt;
        bf16x8 nk[4]; u32x4 nv[2][2];
        { const int ktn = min(kt + 1, 4); ATT_LOAD(ktn, nk, nv); }
        f32x16 S;
#pragma unroll
        for (int i = 0; i < 16; ++i) S[i] = 0.f;
#pragma unroll
        for (int c = 0; c < 4; ++c) S = __builtin_amdgcn_mfma_f32_32x32x16_bf16(ka[c], qb[c], S, 0, 0, 0);
        const int dbase = tq + 128 - 32 * kt - 8 * g;
        unsigned pw[8];
#pragma unroll
        for (int i2 = 0; i2 < 8; ++i2) {
            float p[2];
#pragma unroll
            for (int e = 0; e < 2; ++e) {
                const int i = 2 * i2 + e, ko = 16 * (i >> 3) + (i & 7);
                const int dist = dbase - ko;
                const bool valid = (j0 + 8 * g + ko >= 0) && (dist >= 0) && (dist <= 128);
                const float s2 = S[i] - w.slope2 * (float)dist - Mq;
                p[e] = valid ? __builtin_amdgcn_exp2f(s2) : 0.f;
                lsum += p[e];
            }
            pw[i2] = cvt_pk_bf16(p[0], p[1]);
        }
        bf16x8 pb[2];
        { u32x4 t0 = {pw[0], pw[1], pw[2], pw[3]}, t1 = {pw[4], pw[5], pw[6], pw[7]}; pb[0] = __builtin_bit_cast(bf16x8, t0); pb[1] = __builtin_bit_cast(bf16x8, t1); }
#pragma unroll
        for (int t = 0; t < 2; ++t) {
            LAS unsigned char* wp = stg + (lane & 2) * 512 + (lane >> 2) * 64 + (lane & 1) * 32;
            *(LAS u32x4*)wp = vv[t][0]; *(LAS u32x4*)(wp + 16) = vv[t][1];
            asm volatile("" ::: "memory");
#pragma unroll
            for (int dt = 0; dt < 2; ++dt) {
                const LAS unsigned char* rp = stg + dt * 1024 + (8 * g + ((lane & 15) >> 2)) * 64 + (16 * ((lane >> 4) & 1) + 4 * (lane & 3)) * 2;
                const s16x4 lo4 = __builtin_amdgcn_ds_read_tr16_b64_v4i16((LAS s16x4*)rp), hi4 = __builtin_amdgcn_ds_read_tr16_b64_v4i16((LAS s16x4*)(rp + 256));
                const bf16x8 va = {lo4[0], lo4[1], lo4[2], lo4[3], hi4[0], hi4[1], hi4[2], hi4[3]};
                O[dt] = __builtin_amdgcn_mfma_f32_32x32x16_bf16(va, pb[t], O[dt], 0, 0, 0);
            }
            asm volatile("" ::: "memory");
        }
#pragma unroll
        for (int c = 0; c < 4; ++c) ka[c] = nk[c];
        vv[0][0] = nv[0][0]; vv[0][1] = nv[0][1]; vv[1][0] = nv[1][0]; vv[1][1] = nv[1][1];
    }
#undef ATT_LOAD
    ltot = lsum + __shfl_xor(lsum, 32);
}

template <int NBR>
__device__ __forceinline__ void sample_task(const f32x4 q4, float M, const float* kc, const float* vc, const float* kn, const float* vn, int Lc, int rstride, int i, float slope2, f32x4& O, float& l) {
    O = (f32x4){0.f, 0.f, 0.f, 0.f}; l = 0.f;
#pragma unroll 1
    for (int br = 0; br < NBR; ++br) {
        const int d = 1 << (2 * br);
#pragma unroll 1
        for (int jb = 0; jb < 136; jb += 8) {
            f32x4 k4[8], v4[8];
#pragma unroll
            for (int e = 0; e < 8; ++e) {
                const int j = min(jb + e, 128), idx = Lc + i - j * d;
                const float* kp = idx < Lc ? kc + (size_t)idx * rstride : kn + (size_t)(idx - Lc) * rstride;
                const float* vp = idx < Lc ? vc + (size_t)idx * rstride : vn + (size_t)(idx - Lc) * rstride;
                k4[e] = *(const f32x4*)kp; v4[e] = *(const f32x4*)vp;
            }
#pragma unroll
            for (int e = 0; e < 8; ++e) {
                float dot = q4[0] * k4[e][0] + q4[1] * k4[e][1] + q4[2] * k4[e][2] + q4[3] * k4[e][3];
                dot += __shfl_xor(dot, 1); dot += __shfl_xor(dot, 2); dot += __shfl_xor(dot, 4); dot += __shfl_xor(dot, 8);
                const int j = jb + e;
                const float s2 = dot - slope2 * (float)(j * d) - M;
                const float p = (j <= 128) ? __builtin_amdgcn_exp2f(s2) : 0.f;
                l += p; O = O + v4[e] * p;
            }
        }
    }
}

__device__ __forceinline__ void bar4(LAS unsigned* cnt, unsigned& epoch) {
    asm volatile("s_waitcnt vmcnt(0) lgkmcnt(0)" ::: "memory");
    epoch += 4u;
    if ((threadIdx.x & 63) == 0) {
        __hip_atomic_fetch_add(cnt, 1u, __ATOMIC_RELAXED, __HIP_MEMORY_SCOPE_WORKGROUP);
        while (__hip_atomic_load(cnt, __ATOMIC_RELAXED, __HIP_MEMORY_SCOPE_WORKGROUP) < epoch) __builtin_amdgcn_s_sleep(1);
    }
    asm volatile("" ::: "memory");
}


__device__ __forceinline__ void late_prologue(const Args& a, LAS unsigned char* lds, LAS unsigned* rbc, unsigned& ep, const int aw) {
    const int t = threadIdx.x - 256, lane = t & 63, G = gridDim.x, bid = blockIdx.x;
    unsigned char* ws = a.ws;
    {
        LAS float* T = (LAS float*)lds;
        bf16_t* BT2 = (bf16_t*)(ws + WS_BT2);
        for (int tl = bid; tl < 256; tl += G) {
            const int ct = tl >> 4, dt = tl & 15;
            const int ty = t >> 6, tx = t & 63;
#pragma unroll
            for (int k = 0; k < 16; ++k) { const int dd = ty + 4 * k; T[dd * 65 + tx] = a.in[13][(size_t)(dt * 64 + dd) * DM + ct * 64 + tx]; }
            bar4(rbc, ep);
            const int cc = t >> 2, dsg = t & 3;
#pragma unroll
            for (int hf = 0; hf < 2; ++hf) {
                const int d8 = 16 * dsg + 8 * hf;
                u32x4 w; w.x = cvt_pk_bf16(T[(d8 + 0) * 65 + cc], T[(d8 + 1) * 65 + cc]); w.y = cvt_pk_bf16(T[(d8 + 2) * 65 + cc], T[(d8 + 3) * 65 + cc]);
                w.z = cvt_pk_bf16(T[(d8 + 4) * 65 + cc], T[(d8 + 5) * 65 + cc]); w.w = cvt_pk_bf16(T[(d8 + 6) * 65 + cc], T[(d8 + 7) * 65 + cc]);
                *(u32x4*)(BT2 + (size_t)(ct * 64 + cc) * DM + dt * 64 + d8) = w;
            }
            bar4(rbc, ep);
        }
    }
    {
        LAS float* Kt = (LAS float*)lds;
        LAS float* Wt = Kt + 128 * 129;
        bf16_t* BT3 = (bf16_t*)(ws + WS_BT3);
        for (int tl = bid; tl < 256; tl += G) {
            const int hp = tl >> 4, d0 = (tl & 15) * 64;
            const float* keys = a.in[16] + (size_t)hp * 16384;
#pragma unroll
            for (int k = 0; k < 16; ++k) { const int e = (t + 256 * k) * 4; const f32x4 v = *(const f32x4*)(keys + e); const int n = e >> 7, c = e & 127;
                Kt[n * 129 + c] = v[0]; Kt[n * 129 + c + 1] = v[1]; Kt[n * 129 + c + 2] = v[2]; Kt[n * 129 + c + 3] = v[3]; }
#pragma unroll
            for (int k = 0; k < 8; ++k) { const int e = (t + 256 * k) * 4; const int dd = e >> 7, c = e & 127;
                *(LAS f32x4*)(Wt + dd * 128 + c) = *(const f32x4*)(a.in[15] + (size_t)(d0 + dd) * NPQ + hp * 128 + c); }
            bar4(rbc, ep);
            const int n = t & 127;
#pragma unroll 1
            for (int rep = 0; rep < 2; ++rep) {
                const int dq = (t >> 7) + 2 * rep;
                float acc[16];
#pragma unroll
                for (int j = 0; j < 16; ++j) acc[j] = 0.f;
                for (int c4 = 0; c4 < 32; ++c4) {
                    const float k0 = Kt[n * 129 + 4 * c4], k1 = Kt[n * 129 + 4 * c4 + 1], k2 = Kt[n * 129 + 4 * c4 + 2], k3 = Kt[n * 129 + 4 * c4 + 3];
#pragma unroll
                    for (int j = 0; j < 16; ++j) { const f32x4 w = *(const LAS f32x4*)(Wt + (dq * 16 + j) * 128 + 4 * c4); acc[j] += k0 * w[0] + k1 * w[1] + k2 * w[2] + k3 * w[3]; }
                }
                const float* gf = a.in[14] + d0 + dq * 16;
                u32x4 w0, w1;
                w0.x = cvt_pk_bf16(acc[0] * gf[0], acc[1] * gf[1]); w0.y = cvt_pk_bf16(acc[2] * gf[2], acc[3] * gf[3]); w0.z = cvt_pk_bf16(acc[4] * gf[4], acc[5] * gf[5]); w0.w = cvt_pk_bf16(acc[6] * gf[6], acc[7] * gf[7]);
                w1.x = cvt_pk_bf16(acc[8] * gf[8], acc[9] * gf[9]); w1.y = cvt_pk_bf16(acc[10] * gf[10], acc[11] * gf[11]); w1.z = cvt_pk_bf16(acc[12] * gf[12], acc[13] * gf[13]); w1.w = cvt_pk_bf16(acc[14] * gf[14], acc[15] * gf[15]);
                bf16_t* dst = BT3 + (size_t)(hp * 128 + n) * DM + d0 + dq * 16;
                *(u32x4*)dst = w0; *(u32x4*)(dst + 8) = w1;
            }
            bar4(rbc, ep);
        }
    }
}

__device__ __forceinline__ void tables_fp8(const Args& a, const int widx, const int nwtot) {
    const int lane = threadIdx.x & 63;
    unsigned char* ws = a.ws;
    {
        f32x4 gn[4];
#pragma unroll
        for (int k = 0; k < 4; ++k) gn[k] = *(const f32x4*)(a.in[14] + k * 256 + lane * 4);
        const int rstep = nwtot * 2;
        int r0 = widx * 2;
        f32x4 v[2][4];
#define TB_LOAD(R0, V) do { _Pragma("unroll") for (int rr2 = 0; rr2 < 2; ++rr2) { const int r = min((R0) + rr2, 2 * NEXP - 1); const bool second = r >= NEXP; const int rr = second ? r - NEXP : r; \
            const float* src = (second ? a.in[18] : a.in[17]) + (size_t)rr * DM; _Pragma("unroll") for (int k = 0; k < 4; ++k) V[rr2][k] = __builtin_nontemporal_load((const f32x4*)(src + k * 256 + lane * 4)); } } while (0)
        if (r0 < 2 * NEXP) TB_LOAD(r0, v);
        for (; r0 < 2 * NEXP; r0 += rstep) {
            f32x4 vn[2][4]; float mx[2];
            TB_LOAD(r0 + rstep, vn);
#pragma unroll
            for (int rr2 = 0; rr2 < 2; ++rr2) {
                const bool second = r0 + rr2 >= NEXP;
                float m = 0.f;
#pragma unroll
                for (int k = 0; k < 4; ++k) { if (!second) v[rr2][k] = v[rr2][k] * gn[k]; m = fmaxf(m, fmaxf(fmaxf(fabsf(v[rr2][k][0]), fabsf(v[rr2][k][1])), fmaxf(fabsf(v[rr2][k][2]), fabsf(v[rr2][k][3])))); }
                m = row_max_f(m); m = fmaxf(m, __shfl_xor(m, 16)); m = fmaxf(m, __shfl_xor(m, 32)); mx[rr2] = m;
            }
#pragma unroll
            for (int rr2 = 0; rr2 < 2; ++rr2) {
                const int r = r0 + rr2; const bool second = r >= NEXP; const int rr = second ? r - NEXP : r;
                const float m = mx[rr2], sc = m > 0.f ? 440.0f / m : 1.0f;
                if (lane == 0) ((float*)(ws + WS_USC))[2 * rr + (second ? 1 : 0)] = m > 0.f ? m * (1.0f / 440.0f) : 1.0f;
                unsigned char* dst = ws + (second ? WS_V8 : WS_U8) + (size_t)rr * 128 + (lane & 31) * 4;
#pragma unroll
                for (int k = 0; k < 4; ++k) { unsigned pk = __builtin_amdgcn_cvt_pk_fp8_f32(v[rr2][k][0] * sc, v[rr2][k][1] * sc, 0, false); pk = __builtin_amdgcn_cvt_pk_fp8_f32(v[rr2][k][2] * sc, v[rr2][k][3] * sc, pk, true);
                    *(unsigned*)(dst + (size_t)(2 * k + (lane >> 5)) * SLICE_BYTES) = pk; }
            }
#pragma unroll
            for (int rr2 = 0; rr2 < 2; ++rr2)
#pragma unroll
                for (int k = 0; k < 4; ++k) v[rr2][k] = vn[rr2][k];
        }
#undef TB_LOAD
    }
}

__device__ __forceinline__ void sample_mixer_b(const Args& a, const int wave0, const int NWR) {
    const int tid = threadIdx.x, lane = tid & 63, aw = __builtin_amdgcn_readfirstlane(tid >> 6) - wave0, G = gridDim.x, bid = blockIdx.x;
    unsigned char* ws = a.ws; float* out = a.out;
    const bf16_t* QB = (const bf16_t*)(ws + WS_QB); bf16_t* CAT = (bf16_t*)(ws + WS_CAT);
    const float kbB = wave_max(fabsf(a.in[11][lane])) * 8.0f * 1.01f;
    {
        for (int task = bid * NWR + aw; task < DB * DS * 2; task += G * NWR) {
            const int b = task >> 4, i = (task >> 1) & 7, kv = task & 1, hq = 4 * kv + (lane >> 4), dl = 4 * (lane & 15);
            const int row = NTP + b * DS + i;
            const u32x2 qr = *(const u32x2*)(QB + (size_t)row * 512 + hq * 64 + dl);
            const f32x4 q4 = {bf_lo(qr.x), bf_hi(qr.x), bf_lo(qr.y), bf_hi(qr.y)};
            const float qq = row_sum_f(q4[0] * q4[0] + q4[1] * q4[1] + q4[2] * q4[2] + q4[3] * q4[3]);
            const float sink2 = a.in[12][hq] * LOG2E;
            const float M = fmaxf(sqrtf(qq) * kbB, sink2);
            const size_t co = ((size_t)b * LBW * 2 + kv) * 64 + dl, no = ((size_t)(b * LBW + LBW - DS) * 2 + kv) * 64 + dl;
            f32x4 O; float l;
            sample_task<1>(q4, M, a.in[4] + co, a.in[5] + co, out + O_BKS + no, out + O_BVS + no, LBW, 128, i, alibi_slope(hq) * LOG2E, O, l);
            l += __builtin_amdgcn_exp2f(sink2 - M);
            const float inv = 1.0f / l;
            u32x2 w; w.x = cvt_pk_bf16(O[0] * inv, O[1] * inv); w.y = cvt_pk_bf16(O[2] * inv, O[3] * inv);
            *(u32x2*)(CAT + (size_t)row * DM + 512 + hq * 64 + dl) = w;
        }
        {
            const size_t gtid = (size_t)bid * (NWR * 64) + (tid - wave0 * 64), gstr = (size_t)G * (NWR * 64);
            const size_t perB = (size_t)(LBW - DS) * 128 / 4, totB = perB * DB;
            for (int t = 0; t < 2; ++t) {
                const f32x4* src = (const f32x4*)a.in[4 + t]; f32x4* dst = (f32x4*)(out + (t ? O_BVS : O_BKS));
                for (size_t i = gtid; i < totB; i += gstr) {
                    const size_t b = i / perB, off = i - b * perB;
                    const f32x4 v = __builtin_nontemporal_load(src + b * (LBW * 128 / 4) + DS * 128 / 4 + off);
                    __builtin_nontemporal_store(v, dst + b * (LBW * 128 / 4) + off);
                }
            }
        }
    }
}

__device__ __forceinline__ void p2_attention(const Args& a, LAS unsigned char* lds) {
    const int tid = threadIdx.x, lane = tid & 63, wave = __builtin_amdgcn_readfirstlane(tid >> 6), G = gridDim.x, bid = blockIdx.x;
    unsigned char* ws = a.ws; float* out = a.out;
    const bf16_t* QA = (const bf16_t*)(ws + WS_QA); const bf16_t* KA = (const bf16_t*)(ws + WS_KA); const bf16_t* VA = (const bf16_t*)(ws + WS_VAT);
    const bf16_t* QB = (const bf16_t*)(ws + WS_QB); const bf16_t* KB = (const bf16_t*)(ws + WS_KB); const bf16_t* VBN = (const bf16_t*)(ws + WS_VBT);
    bf16_t* CAT = (bf16_t*)(ws + WS_CAT);
    LAS unsigned* rb = (LAS unsigned*)(lds + LDS_BARW - 16);
    if (tid < 2) rb[tid] = 0u;
    __syncthreads();
    {
        constexpr int NWR = 8;
        const int aw = wave;
        const float kbA = wave_max(fabsf(a.in[9][lane])) * 8.0f * 1.01f, kbB = wave_max(fabsf(a.in[11][lane])) * 8.0f * 1.01f;
        const int tq = lane & 31, g = lane >> 5;
        LAS unsigned char* stg = lds + 141312 + aw * 2048;
        unsigned ep = 0u;
        for (int wt = bid * NWR + aw; wt < NB * 8 * (SEQ / 32); wt += G * NWR) {
            const int b = wt >> 10, hq = (wt >> 7) & 7, T = wt & 127, kv = hq >> 2, i0 = 32 * T;
            WT w; w.q = QB + ((size_t)(b * SEQ + i0)) * 512 + hq * 64; w.qstride = 512;
            w.k = KB + ((size_t)b * SEQ) * 128 + kv * 64; w.v = VBN + ((size_t)b * SEQ) * 128 + kv * 64; w.kstride = 128;
            w.i0 = i0; w.slope2 = alibi_slope(hq) * LOG2E;
            const float sink2 = a.in[12][hq] * LOG2E;
            f32x16 O[2]; float l, Mq;
            attn_tile(w, kbB, sink2, stg, O, l, Mq);
            l += __builtin_amdgcn_exp2f(sink2 - Mq);
            const float inv = 1.0f / l;
            bf16_t* dst = CAT + (size_t)(b * SEQ + i0 + tq) * DM + 512 + hq * 64;
#pragma unroll
            for (int dt = 0; dt < 2; ++dt)
#pragma unroll
                for (int i4 = 0; i4 < 4; ++i4) {
                    u32x2 pkw; pkw.x = cvt_pk_bf16(O[dt][4 * i4] * inv, O[dt][4 * i4 + 1] * inv); pkw.y = cvt_pk_bf16(O[dt][4 * i4 + 2] * inv, O[dt][4 * i4 + 3] * inv);
                    *(u32x2*)(dst + 32 * dt + 8 * i4 + 4 * g) = pkw;
                }
        }
        {
            LAS float* ACC = (LAS float*)lds;
            LAS float* LS = ACC + 512 * 68;
            for (int unit = bid; unit < NB * 8 * (SEQ / 512); unit += G) {
                const int b = unit >> 6, h = (unit >> 3) & 7, q0 = (unit & 7) * 512;
#pragma unroll 1
                for (int pass = 0; pass < 3; ++pass) {
                    const int sh = 2 * pass, d = 1 << sh;
#pragma unroll 1
                    for (int tt = 0; tt < 16 / NWR; ++tt) {
                        const int T = aw + NWR * tt;
                        int res, i0, qlb, qls;
                        if (pass == 0) { res = 0; i0 = q0 + 32 * T; qlb = 32 * T; qls = 1; }
                        else if (pass == 1) { res = T >> 2; i0 = (q0 >> 2) + 32 * (T & 3); qlb = 128 * (T & 3) + res; qls = 4; }
                        else { res = T; i0 = q0 >> 4; qlb = res; qls = 16; }
                        WT w; w.q = QA + ((size_t)(b * SEQ + res) + (size_t)i0 * d) * 512 + h * 64; w.qstride = (size_t)d * 512;
                        w.k = KA + ((size_t)(b * SEQ + res)) * 512 + h * 64; w.v = VA + ((size_t)(b * SEQ + res)) * 512 + h * 64; w.kstride = (size_t)d * 512;
                        w.i0 = i0; w.slope2 = alibi_slope(h) * (float)d * LOG2E;
                        f32x16 O[2]; float l, Mq;
                        attn_tile(w, kbA, -3.0e38f, stg, O, l, Mq);
                        const int ql = qlb + tq * qls;
                        LAS float* ar = ACC + ql * 68 + 4 * g;
                        if (pass == 0) {
#pragma unroll
                            for (int dt = 0; dt < 2; ++dt)
#pragma unroll
                                for (int i4 = 0; i4 < 4; ++i4) *(LAS f32x4*)(ar + 32 * dt + 8 * i4) = (f32x4){O[dt][4 * i4], O[dt][4 * i4 + 1], O[dt][4 * i4 + 2], O[dt][4 * i4 + 3]};
                            if (g == 0) LS[ql] = l;
                        } else if (pass == 1) {
#pragma unroll
                            for (int dt = 0; dt < 2; ++dt)
#pragma unroll
                                for (int i4 = 0; i4 < 4; ++i4) { const f32x4 o = *(LAS f32x4*)(ar + 32 * dt + 8 * i4); *(LAS f32x4*)(ar + 32 * dt + 8 * i4) = o + (f32x4){O[dt][4 * i4], O[dt][4 * i4 + 1], O[dt][4 * i4 + 2], O[dt][4 * i4 + 3]}; }
                            if (g == 0) LS[ql] += l;
                        } else {
                            const float inv = 1.0f / (LS[ql] + l);
                            bf16_t* dst = CAT + (size_t)(b * SEQ + q0 + ql) * DM + h * 64 + 4 * g;
#pragma unroll
                            for (int dt = 0; dt < 2; ++dt)
#pragma unroll
                                for (int i4 = 0; i4 < 4; ++i4) {
                                    const f32x4 o = *(LAS f32x4*)(ar + 32 * dt + 8 * i4);
                                    u32x2 pkw; pkw.x = cvt_pk_bf16((o[0] + O[dt][4 * i4]) * inv, (o[1] + O[dt][4 * i4 + 1]) * inv); pkw.y = cvt_pk_bf16((o[2] + O[dt][4 * i4 + 2]) * inv, (o[3] + O[dt][4 * i4 + 3]) * inv);
                                    *(u32x2*)(dst + 32 * dt + 8 * i4) = pkw;
                                }
                        }
                    }
                    if (NWR == 8) __syncthreads(); else bar4(rb + 1, ep);
                }
            }
        }
        if (CONV_IN_P1 && G == 256) { }
        else if (wave >= 4) late_prologue(a, lds, rb + 1, ep, wave - 4); else tables_fp8(a, bid * 4 + wave, G * 4);
    }
    __syncthreads();
}

__device__ __forceinline__ float gelu_erf(float x) { return 0.5f * x * (1.0f + erff(x * 0.70710678118654752f)); }

template <int GS> __device__ __forceinline__ void bisect16(const float (&x)[32], float& lo, float& hi) {
    float mx = x[0], mn = x[0];
#pragma unroll
    for (int j = 1; j < 32; ++j) { mx = fmaxf(mx, x[j]); mn = fminf(mn, x[j]); }
    hi = grp_max_f<GS>(mx); lo = grp_min_f<GS>(mn);
    bool done = false;
#pragma unroll 1
    for (int it = 0; it < 48; ++it) {
        const float t = 0.5f * (lo + hi);
        const bool conv = !(t > lo && t < hi);
        int cnt = 0;
#pragma unroll
        for (int j = 0; j < 32; ++j) cnt += (x[j] >= t) ? 1 : 0;
        cnt = grp_sum_i<GS>(cnt);
        const bool upd = !done && !conv, ex = cnt == 16, gt = cnt > 16;
        const float nlo = (ex || gt) ? t : lo, nhi = (ex || !gt) ? t : hi;
        lo = upd ? nlo : lo; hi = upd ? nhi : hi;
        done = done || conv || ex;
        if (__ballot(!done) == 0ull) break;
    }
}

__device__ __forceinline__ void peer_select(const float* S, const int row, const int lane, LAS float* sv, LAS int* si, LAS float* fvL, LAS int* eL, int& e0o, int& e1o, float& g0o, float& g1o) {
        {
            const int grp = lane >> 2, qtr = lane & 3;
            float x[32];
            const float* sp = S + (size_t)row * NPQ + grp * 128 + qtr * 32;
#pragma unroll
            for (int k = 0; k < 8; ++k) { const f32x4 v = *(const f32x4*)(sp + 4 * k); x[4 * k] = v[0]; x[4 * k + 1] = v[1]; x[4 * k + 2] = v[2]; x[4 * k + 3] = v[3]; }
            float lo, hi;
            bisect16<4>(x, lo, hi);
            int cA = 0, cB = 0;
#pragma unroll
            for (int j = 0; j < 32; ++j) { cA += (x[j] >= hi) ? 1 : 0; cB += (x[j] >= lo && x[j] < hi) ? 1 : 0; }
            const int pk = cA | (cB << 8);
            const int q0 = dpp_i<0x00>(pk), q1 = dpp_i<0x55>(pk), q2 = dpp_i<0xAA>(pk), q3 = dpp_i<0xFF>(pk);
            const int tot = q0 + q1 + q2 + q3, pre = (qtr > 0 ? q0 : 0) + (qtr > 1 ? q1 : 0) + (qtr > 2 ? q2 : 0);
            int pA = pre & 255, pB = (tot & 255) + (pre >> 8);
            asm volatile("" : "+v"(lo), "+v"(hi));
#pragma unroll
            for (int j = 0; j < 32; ++j) {
                const bool isA = x[j] >= hi, isB = !isA && x[j] >= lo;
                const int slot = isA ? pA : pB;
                if ((isA || isB) && slot < 16) { sv[grp * 16 + slot] = x[j]; si[grp * 16 + slot] = qtr * 32 + j; }
                pA += isA ? 1 : 0; pB += isB ? 1 : 0;
            }
        }
        __builtin_amdgcn_wave_barrier();
        {
            const int hd = lane >> 3, sub = lane & 7;
            const float s1a = sv[(2 * hd) * 16 + 2 * sub], s1b = sv[(2 * hd) * 16 + 2 * sub + 1];
            const int i1a = si[(2 * hd) * 16 + 2 * sub], i1b = si[(2 * hd) * 16 + 2 * sub + 1];
            float c[32]; int i2[16];
#pragma unroll
            for (int k = 0; k < 4; ++k) {
                const f32x4 v = *(const LAS f32x4*)(sv + (2 * hd + 1) * 16 + 4 * k);
                const u32x4 iv = *(const LAS u32x4*)(si + (2 * hd + 1) * 16 + 4 * k);
#pragma unroll
                for (int e = 0; e < 4; ++e) { c[4 * k + e] = s1a + v[e]; c[16 + 4 * k + e] = s1b + v[e]; }
                i2[4 * k] = (int)iv.x; i2[4 * k + 1] = (int)iv.y; i2[4 * k + 2] = (int)iv.z; i2[4 * k + 3] = (int)iv.w;
            }
            float lo, hi;
            bisect16<8>(c, lo, hi);
            int cA = 0, cB = 0;
#pragma unroll
            for (int j = 0; j < 32; ++j) { cA += (c[j] >= hi) ? 1 : 0; cB += (c[j] >= lo && c[j] < hi) ? 1 : 0; }
            const int pk = cA | (cB << 8);
            int inc = pk;
            { int t = __shfl_up(inc, 1, 8); if (sub >= 1) inc += t; t = __shfl_up(inc, 2, 8); if (sub >= 2) inc += t; t = __shfl_up(inc, 4, 8); if (sub >= 4) inc += t; }
            const int tot = __shfl(inc, 7, 8), pre = inc - pk;
            int pA = pre & 255, pB = (tot & 255) + (pre >> 8);
            asm volatile("" : "+v"(lo), "+v"(hi));
#pragma unroll
            for (int j = 0; j < 32; ++j) {
                const bool isA = c[j] >= hi, isB = !isA && c[j] >= lo;
                const int slot = isA ? pA : pB;
                if ((isA || isB) && slot < 16) { fvL[hd * 16 + slot] = c[j]; eL[hd * 16 + slot] = (j < 16 ? i1a : i1b) * 128 + i2[j & 15]; }
                pA += isA ? 1 : 0; pB += isB ? 1 : 0;
            }
        }
        __builtin_amdgcn_wave_barrier();
        const int e0 = eL[lane], e1 = eL[64 + lane];
        float g0, g1;
        { const float f0 = fvL[lane], f1 = fvL[64 + lane];
          const float p0 = __expf(f0 - row_max_f(f0)), p1 = __expf(f1 - row_max_f(f1));
          g0 = p0 / row_sum_f(p0); g1 = p1 / row_sum_f(p1); }
        e0o = e0; e1o = e1; g0o = g0; g1o = g1;
}

typedef float f32x2 __attribute__((ext_vector_type(2)));
__device__ __forceinline__ f32x2 fp8x2_lo(unsigned w) { return __builtin_amdgcn_cvt_pk_f32_fp8(w, false); }
__device__ __forceinline__ f32x2 fp8x2_hi(unsigned w) { return __builtin_amdgcn_cvt_pk_f32_fp8(w, true); }
template <int CTRL, int BANK> __device__ __forceinline__ float dpp_bank_f(float old, float x) { return __uint_as_float((unsigned)__builtin_amdgcn_update_dpp((int)__float_as_uint(old), (int)__float_as_uint(x), CTRL, 0xf, BANK, false)); }
__device__ __forceinline__ float xor4_f(float x) { float r = dpp_bank_f<0x104, 0x5>(0.f, x); return dpp_bank_f<0x114, 0xa>(r, x); }

__device__ __forceinline__ void peer_topk_w(const Args& a, LAS unsigned char* lds, const int widx, const int nwtot, const int row_lo, const int row_hi);
__device__ __forceinline__ void peer_topk(const Args& a, LAS unsigned char* lds, const int wave0, const int nw, const int row_lo, const int row_hi) {
    const int wave = __builtin_amdgcn_readfirstlane(threadIdx.x >> 6) - wave0;
    peer_topk_w(a, lds, (int)blockIdx.x * nw + wave, (int)gridDim.x * nw, row_lo, row_hi);
}
__device__ __forceinline__ void peer_topk_w(const Args& a, LAS unsigned char* lds, const int widx, const int nwtot, const int row_lo, const int row_hi) {
    const int tid = threadIdx.x, lane = tid & 63;
    unsigned char* ws = a.ws;
    const float* S = (const float*)(ws + WS_S);
    LAS float* sv = (LAS float*)(lds + __builtin_amdgcn_readfirstlane(tid >> 6) * 3072); LAS int* si = (LAS int*)(sv + 256); LAS float* fvL = (LAS float*)(si + 256); LAS int* eL = (LAS int*)(fvL + 128);
    for (int row = row_lo + widx; row < row_hi; row += nwtot) {
        int e0, e1; float g0, g1;
        peer_select(S, row, lane, sv, si, fvL, eL, e0, e1, g0, g1);
        unsigned* kp = (unsigned*)(ws + WS_PEERK) + (size_t)row * 256;
        kp[lane] = (unsigned)e0; kp[64 + lane] = (unsigned)e1; kp[128 + lane] = __float_as_uint(g0); kp[192 + lane] = __float_as_uint(g1);
        __builtin_amdgcn_wave_barrier();
    }
}

struct PeerWork { int j, q0, qstep, nq, W, OFF, row_lo; };
__device__ __forceinline__ int peer_tok(const PeerWork& w, const int q) { return w.row_lo + (q / w.W) * 16 + w.OFF + (q % w.W); }
__device__ __forceinline__ PeerWork peer_work_plain(const int wave, const int nw, const int NI, const int row_lo, const int row_hi) {
    const int bid = blockIdx.x; PeerWork w; w.j = bid & 7; w.q0 = (bid >> 3) + NI * wave; w.qstep = NI * nw; w.nq = row_hi - row_lo; w.W = 16; w.OFF = 0; w.row_lo = row_lo; return w;
}

template <bool NT>
__device__ __forceinline__ void peer_passA(const Args& a, const PeerWork w) {
    const int lane = threadIdx.x & 63;
    const int j = w.j, r = lane >> 3, sub = lane & 7;
    unsigned char* ws = a.ws;
    const unsigned char* Us = ws + WS_U8 + (size_t)j * SLICE_BYTES; const unsigned sub16 = 16u * (unsigned)sub;
    const unsigned* KP = (const unsigned*)(ws + WS_PEERK) + 16 * r;
    const float* H = (const float*)(ws + WS_H) + 128 * j + 16 * sub;
    float* PD = (float*)(ws + WS_PD) + 128 * j + 2 * lane;
    const int qs = w.qstep, ql = w.nq - 1;
    int q = w.q0;
    if (q > ql) return;
    u32x4 idv[4], ur[16]; f32x4 hv[4];
#define PA_LD(P) (NT ? __builtin_nontemporal_load((const u32x4*)(P)) : *(const u32x4*)(P))
#define PA_IDS(T) do { const unsigned* kp_ = KP + (size_t)(T) * 256; _Pragma("unroll") for (int qq = 0; qq < 4; ++qq) idv[qq] = *(const u32x4*)(kp_ + 4 * qq); } while (0)
#define PA_GATHER(T, UR, HV) do { _Pragma("unroll") for (int qq = 0; qq < 4; ++qq) { UR[4 * qq] = PA_LD(Us + (idv[qq].x * 128u + sub16)); UR[4 * qq + 1] = PA_LD(Us + (idv[qq].y * 128u + sub16)); \
            UR[4 * qq + 2] = PA_LD(Us + (idv[qq].z * 128u + sub16)); UR[4 * qq + 3] = PA_LD(Us + (idv[qq].w * 128u + sub16)); } \
        const float* hp_ = H + (size_t)(T) * DM; _Pragma("unroll") for (int qq = 0; qq < 4; ++qq) HV[qq] = *(const f32x4*)(hp_ + 4 * qq); } while (0)
    int t = peer_tok(w, q), t1 = peer_tok(w, min(q + qs, ql));
    PA_IDS(t);
    PA_GATHER(t, ur, hv);
    PA_IDS(t1);
#pragma unroll 1
    for (;; q += qs) {
        u32x4 urn[16]; f32x4 hn[4];
        PA_GATHER(t1, urn, hn);
        const int t2 = peer_tok(w, min(q + 2 * qs, ql));
        PA_IDS(t2);
        float part[16];
#pragma unroll
        for (int k = 0; k < 16; ++k) {
            const unsigned ww[4] = {ur[k].x, ur[k].y, ur[k].z, ur[k].w};
            f32x2 p2 = {0.f, 0.f};
#pragma unroll
            for (int wd = 0; wd < 4; ++wd) { p2 = __builtin_elementwise_fma(fp8x2_lo(ww[wd]), (f32x2){hv[wd][0], hv[wd][1]}, p2); p2 = __builtin_elementwise_fma(fp8x2_hi(ww[wd]), (f32x2){hv[wd][2], hv[wd][3]}, p2); }
            part[k] = p2[0] + p2[1];
        }
        float w8[8], w4[4], w2[2];
        { const bool up = (lane & 4) != 0;
#pragma unroll
          for (int m = 0; m < 8; ++m) { const float keep = up ? part[m + 8] : part[m], send = up ? part[m] : part[m + 8]; w8[m] = keep + xor4_f(send); } }
        { const bool up = (lane & 2) != 0;
#pragma unroll
          for (int m = 0; m < 4; ++m) { const float keep = up ? w8[m + 4] : w8[m], send = up ? w8[m] : w8[m + 4]; w4[m] = keep + dpp_f<0x4E>(send); } }
        { const bool up = (lane & 1) != 0;
#pragma unroll
          for (int m = 0; m < 2; ++m) { const float keep = up ? w4[m + 2] : w4[m], send = up ? w4[m] : w4[m + 2]; w2[m] = keep + dpp_f<0xB1>(send); } }
        *(f32x2*)(PD + (size_t)t * 1024) = (f32x2){w2[0], w2[1]};
        if (q + qs > ql) break;
#pragma unroll
        for (int k = 0; k < 16; ++k) ur[k] = urn[k];
#pragma unroll
        for (int qq = 0; qq < 4; ++qq) hv[qq] = hn[qq];
        t = t1; t1 = t2;
    }
#undef PA_LD
#undef PA_IDS
#undef PA_GATHER
}

__device__ __forceinline__ void peer_coef(const Args& a, const int widx, const int nwtot, const int row_lo, const int row_hi) {
    const int lane = threadIdx.x & 63, half = lane >> 5, l5 = lane & 31;
    unsigned char* ws = a.ws;
    const f32x2* SC = (const f32x2*)(ws + WS_USC); const float* rowss = (const float*)(ws + WS_ROWSS);
    for (int row = row_lo + widx; row < row_hi; row += nwtot) {
        const unsigned* kp = (const unsigned*)(ws + WS_PEERK) + (size_t)row * 256 + 4 * l5;
        const float* pd = (const float*)(ws + WS_PD) + (size_t)row * 1024 + half * 512 + 4 * l5;
        const u32x4 ids = *(const u32x4*)kp;
        const f32x4 g = *(const f32x4*)(kp + 128);
        f32x4 d = *(const f32x4*)pd;
#pragma unroll
        for (int sl = 1; sl < 4; ++sl) d = d + *(const f32x4*)(pd + sl * 128);
        const f32x2 s0 = SC[ids.x], s1 = SC[ids.y], s2 = SC[ids.z], s3 = SC[ids.w];
        const float rs2 = rsqrtf(rowss[row] * (1.0f / DM) + EPS);
#pragma unroll
        for (int c = 0; c < 4; ++c) d[c] += __shfl_xor(d[c], 32);
        f32x4 cf;
        cf[0] = g[0] * gelu_erf(d[0] * rs2 * s0[0]) * s0[1]; cf[1] = g[1] * gelu_erf(d[1] * rs2 * s1[0]) * s1[1];
        cf[2] = g[2] * gelu_erf(d[2] * rs2 * s2[0]) * s2[1]; cf[3] = g[3] * gelu_erf(d[3] * rs2 * s3[0]) * s3[1];
        if (half == 0) *(f32x4*)((float*)(ws + WS_COEF) + (size_t)row * 128 + 4 * l5) = cf;
    }
}

template <bool NT>
__device__ __forceinline__ void peer_passB(const Args& a, const PeerWork w) {
    const int lane = threadIdx.x & 63;
    const int j = w.j, r = lane >> 3, sub = lane & 7;
    unsigned char* ws = a.ws;
    const unsigned char* Vs = ws + WS_V8 + (size_t)j * SLICE_BYTES; const unsigned sub16 = 16u * (unsigned)sub;
    const unsigned* KP = (const unsigned*)(ws + WS_PEERK) + 16 * r;
    const float* CO = (const float*)(ws + WS_COEF) + 16 * r;
    const float* H = (const float*)(ws + WS_H) + 128 * j + 16 * sub + 2 * r;
    float* Y = a.out + 128 * j + 16 * sub + 2 * r;
    const int qs = w.qstep, ql = w.nq - 1;
    int q = w.q0;
    if (q > ql) return;
    u32x4 idv[4], vr[16]; f32x4 cf[4]; f32x2 hv;
#define PB_LD(P) (NT ? __builtin_nontemporal_load((const u32x4*)(P)) : *(const u32x4*)(P))
#define PB_IDS(T) do { const unsigned* kp_ = KP + (size_t)(T) * 256; _Pragma("unroll") for (int qq = 0; qq < 4; ++qq) idv[qq] = *(const u32x4*)(kp_ + 4 * qq); } while (0)
#define PB_GATHER(T, VR, CF, HV) do { _Pragma("unroll") for (int qq = 0; qq < 4; ++qq) { VR[4 * qq] = PB_LD(Vs + (idv[qq].x * 128u + sub16)); VR[4 * qq + 1] = PB_LD(Vs + (idv[qq].y * 128u + sub16)); \
            VR[4 * qq + 2] = PB_LD(Vs + (idv[qq].z * 128u + sub16)); VR[4 * qq + 3] = PB_LD(Vs + (idv[qq].w * 128u + sub16)); } \
        const float* cp_ = CO + (size_t)(T) * 128; _Pragma("unroll") for (int qq = 0; qq < 4; ++qq) CF[qq] = *(const f32x4*)(cp_ + 4 * qq); \
        HV = *(const f32x2*)(H + (size_t)(T) * DM); } while (0)
    int t = peer_tok(w, q), t1 = peer_tok(w, min(q + qs, ql));
    PB_IDS(t);
    PB_GATHER(t, vr, cf, hv);
    PB_IDS(t1);
#pragma unroll 1
    for (;; q += qs) {
        u32x4 vrn[16]; f32x4 cfn[4]; f32x2 hn;
        PB_GATHER(t1, vrn, cfn, hn);
        const int t2 = peer_tok(w, min(q + 2 * qs, ql));
        PB_IDS(t2);
        f32x2 acc[8];
#pragma unroll
        for (int m = 0; m < 8; ++m) acc[m] = (f32x2){0.f, 0.f};
#pragma unroll
        for (int k = 0; k < 16; ++k) {
            const unsigned ww[4] = {vr[k].x, vr[k].y, vr[k].z, vr[k].w};
            const float c = cf[k >> 2][k & 3]; const f32x2 c2 = {c, c};
#pragma unroll
            for (int wd = 0; wd < 4; ++wd) { acc[2 * wd] = __builtin_elementwise_fma(fp8x2_lo(ww[wd]), c2, acc[2 * wd]); acc[2 * wd + 1] = __builtin_elementwise_fma(fp8x2_hi(ww[wd]), c2, acc[2 * wd + 1]); }
        }
        float w8[8], w4[4], w2[2];
#pragma unroll
        for (int m = 0; m < 8; ++m) { const auto sw = __builtin_amdgcn_permlane32_swap(__float_as_uint(acc[m >> 1][m & 1]), __float_as_uint(acc[(m + 8) >> 1][m & 1]), false, false); w8[m] = __uint_as_float(sw[0]) + __uint_as_float(sw[1]); }
#pragma unroll
        for (int m = 0; m < 4; ++m) { const auto sw = __builtin_amdgcn_permlane16_swap(__float_as_uint(w8[m]), __float_as_uint(w8[m + 4]), false, false); w4[m] = __uint_as_float(sw[0]) + __uint_as_float(sw[1]); }
        { const bool up = (lane & 8) != 0;
#pragma unroll
          for (int m = 0; m < 2; ++m) { const float keep = up ? w4[m + 2] : w4[m], send = up ? w4[m] : w4[m + 2]; w2[m] = keep + dpp_f<0x128>(send); } }
        *(f32x2*)(Y + (size_t)t * DM) = (f32x2){hv[0] + w2[0], hv[1] + w2[1]};
        if (q + qs > ql) break;
#pragma unroll
        for (int k = 0; k < 16; ++k) vr[k] = vrn[k];
#pragma unroll
        for (int qq = 0; qq < 4; ++qq) cf[qq] = cfn[qq];
        hv = hn;
        t = t1; t1 = t2;
    }
#undef PB_LD
#undef PB_IDS
#undef PB_GATHER
}

__device__ __forceinline__ void stream_task(const Args& a, const int task, const int wave, const float kbA, LAS unsigned* rb, unsigned& ep) {
    const int lane = threadIdx.x & 63;
    unsigned char* ws = a.ws; float* out = a.out;
    const bf16_t* QA = (const bf16_t*)(ws + WS_QA); bf16_t* CAT = (bf16_t*)(ws + WS_CAT);
    {
            const int b = task >> 1, hh = task & 1, hd = 4 * hh + (lane >> 4), dl = 4 * (lane & 15);
            const float slope2 = alibi_slope(hd) * LOG2E;
            f32x4 q[8], O[8]; float M[8], l[8];
#pragma unroll
            for (int i = 0; i < 8; ++i) {
                const u32x2 qr = *(const u32x2*)(QA + (size_t)(NTP + b * DS + i) * 512 + hd * 64 + dl);
                q[i] = (f32x4){bf_lo(qr.x), bf_hi(qr.x), bf_lo(qr.y), bf_hi(qr.y)};
                M[i] = sqrtf(row_sum_f(q[i][0] * q[i][0] + q[i][1] * q[i][1] + q[i][2] * q[i][2] + q[i][3] * q[i][3])) * kbA;
                O[i] = (f32x4){0.f, 0.f, 0.f, 0.f}; l[i] = 0.f;
            }
            const f32x4 qa = wave == 0 ? q[0] : wave == 1 ? q[1] : wave == 2 ? q[2] : q[3], qb = wave == 0 ? q[4] : wave == 1 ? q[5] : wave == 2 ? q[6] : q[7];
            const float Ma = wave == 0 ? M[0] : wave == 1 ? M[1] : wave == 2 ? M[2] : M[3], Mb = wave == 0 ? M[4] : wave == 1 ? M[5] : wave == 2 ? M[6] : M[7];
            f32x4 Oa = {0.f, 0.f, 0.f, 0.f}, Ob = {0.f, 0.f, 0.f, 0.f}; float la = 0.f, lb = 0.f;
            const size_t co = ((size_t)b * LA * 8 + hd) * 64 + dl;
            const float* kc = a.in[2] + co; const float* vc = a.in[3] + co; float* ko = out + O_AKS + co; float* vo = out + O_AVS + co;
            constexpr int NGRP = 480 / SB;
            int gq = 0;
            f32x4 k4[SB], v4[SB];
#pragma unroll
            for (int u = 0; u < SB; ++u) { const size_t ro = (size_t)(wave + 4 * (SB * gq + u)) * 512; k4[u] = __builtin_nontemporal_load((const f32x4*)(kc + ro)); v4[u] = __builtin_nontemporal_load((const f32x4*)(vc + ro)); }
#pragma unroll 1
            for (int it = 0; it < NGRP; ++it) {
                const int n0 = SB * gq;
                gq = gq + 1 == NGRP ? 0 : gq + 1;
                f32x4 kn4[SB], vn4[SB];
#pragma unroll
                for (int u = 0; u < SB; ++u) { const size_t ro = (size_t)(wave + 4 * (SB * gq + u)) * 512; kn4[u] = __builtin_nontemporal_load((const f32x4*)(kc + ro)); vn4[u] = __builtin_nontemporal_load((const f32x4*)(vc + ro)); }
#pragma unroll
                for (int u = 0; u < SB; ++u) {
                    const int n = n0 + u;
                    if (n >= 2) { const size_t wo = (size_t)(wave + 4 * n - DS) * 512; __builtin_nontemporal_store(k4[u], (f32x4*)(ko + wo)); __builtin_nontemporal_store(v4[u], (f32x4*)(vo + wo)); }
                    const int da = LA - 4 * n, db = da + 4;
                    const int ma = (da <= 512 ? 1 : 0) + ((da & 15) == 0 ? 1 : 0), mb = (db <= 512 ? 1 : 0) + ((db & 15) == 0 ? 1 : 0);
                    if (ma) {
                        const float dot = row_sum_f(qa[0] * k4[u][0] + qa[1] * k4[u][1] + qa[2] * k4[u][2] + qa[3] * k4[u][3]);
                        const float pp = __builtin_amdgcn_exp2f(dot - slope2 * (float)da - Ma) * (float)ma;
                        la += pp; Oa = Oa + v4[u] * pp;
                    }
                    if (mb) {
                        const float dot = row_sum_f(qb[0] * k4[u][0] + qb[1] * k4[u][1] + qb[2] * k4[u][2] + qb[3] * k4[u][3]);
                        const float pp = __builtin_amdgcn_exp2f(dot - slope2 * (float)db - Mb) * (float)mb;
                        lb += pp; Ob = Ob + v4[u] * pp;
                    }
                }
#pragma unroll
                for (int u = 0; u < SB; ++u) { k4[u] = kn4[u]; v4[u] = vn4[u]; }
            }
#pragma unroll 1
            for (int n0 = 480; n0 < 512; n0 += 4) {
                f32x4 k4[4], v4[4];
#pragma unroll
                for (int u = 0; u < 4; ++u) { const size_t ro = (size_t)(wave + 4 * (n0 + u)) * 512; k4[u] = __builtin_nontemporal_load((const f32x4*)(kc + ro)); v4[u] = __builtin_nontemporal_load((const f32x4*)(vc + ro)); }
#pragma unroll
                for (int u = 0; u < 4; ++u) {
                    const int r = wave + 4 * (n0 + u);
                    { const size_t wo = (size_t)(r - DS) * 512; __builtin_nontemporal_store(k4[u], (f32x4*)(ko + wo)); __builtin_nontemporal_store(v4[u], (f32x4*)(vo + wo)); }
#pragma unroll
                    for (int i = 0; i < 8; ++i) {
                        const int dist = LA + i - r;
                        const int mult = (dist <= 128 ? 1 : 0) + ((dist & 3) == 0 ? 1 : 0) + ((dist & 15) == 0 ? 1 : 0);
                        if (mult) {
                            const float dot = row_sum_f(q[i][0] * k4[u][0] + q[i][1] * k4[u][1] + q[i][2] * k4[u][2] + q[i][3] * k4[u][3]);
                            const float pp = __builtin_amdgcn_exp2f(dot - slope2 * (float)dist - M[i]) * (float)mult;
                            l[i] += pp; O[i] = O[i] + v4[u] * pp;
                        }
                    }
                }
            }
#pragma unroll
            for (int nn = 0; nn < 2; ++nn) {
                const int nr = wave + 4 * nn;
                const size_t no = (size_t)(LA - DS + nr) * 512;
                const f32x4 kn = *(const f32x4*)(ko + no), vn = *(const f32x4*)(vo + no);
#pragma unroll
                for (int i = 0; i < 8; ++i) {
                    const int dist = i - nr;
                    if (dist >= 0) {
                        const int mult = 1 + ((dist & 3) == 0 ? 1 : 0) + (dist == 0 ? 1 : 0);
                        const float dot = row_sum_f(q[i][0] * kn[0] + q[i][1] * kn[1] + q[i][2] * kn[2] + q[i][3] * kn[3]);
                        const float pp = __builtin_amdgcn_exp2f(dot - slope2 * (float)dist - M[i]) * (float)mult;
                        l[i] += pp; O[i] = O[i] + vn * pp;
                    }
                }
            }
#pragma unroll
            for (int i = 0; i < 4; ++i) if (i == wave) { O[i] = O[i] + Oa; l[i] += la; O[i + 4] = O[i + 4] + Ob; l[i + 4] += lb; }
            f32x4* PO = (f32x4*)(ws + WS_SPART + (size_t)task * 40960);
            float* PL = (float*)(ws + WS_SPART + (size_t)task * 40960 + 32768);
#pragma unroll
            for (int i = 0; i < 8; ++i) { PO[(wave * 8 + i) * 64 + lane] = O[i]; PL[(wave * 8 + i) * 64 + lane] = l[i]; }
            bar4(rb, ep);
#pragma unroll
            for (int nn = 0; nn < 2; ++nn) {
                const int i = wave + 4 * nn;
                f32x4 Os = {0.f, 0.f, 0.f, 0.f}; float ls = 0.f;
#pragma unroll
                for (int w2 = 0; w2 < 4; ++w2) { Os = Os + __builtin_nontemporal_load(PO + (w2 * 8 + i) * 64 + lane); ls += __builtin_nontemporal_load(PL + (w2 * 8 + i) * 64 + lane); }
                const float inv = 1.0f / ls;
                u32x2 wv; wv.x = cvt_pk_bf16(Os[0] * inv, Os[1] * inv); wv.y = cvt_pk_bf16(Os[2] * inv, Os[3] * inv);
                *(u32x2*)(CAT + (size_t)(NTP + b * DS + i) * DM + hd * 64 + dl) = wv;
            }
    }
}

#define XB_PB(k) (32 * (k))
__device__ __forceinline__ void peer_barrier(unsigned* bar, const int k, const unsigned expected) {
    asm volatile("s_waitcnt vmcnt(0)" ::: "memory");
    __syncthreads();
    if (threadIdx.x == 0) {
        __builtin_amdgcn_fence(__ATOMIC_RELEASE, "agent");
        asm volatile("s_waitcnt vmcnt(0)" ::: "memory");
        (void)xb_add(&bar[XB_PB(k)], 1u);
        XB_SPIN(xb_ld(&bar[XB_PB(k)]) < expected, bar);
        __builtin_amdgcn_fence(__ATOMIC_ACQUIRE, "agent");
        asm volatile("s_waitcnt vmcnt(0)" ::: "memory");
    }
    __syncthreads();
}
__device__ __forceinline__ void p5a_stream_select(const Args& a, LAS unsigned char* lds) {
    const int tid = threadIdx.x, lane = tid & 63, wave = __builtin_amdgcn_readfirstlane(tid >> 6), G = gridDim.x, bid = blockIdx.x;
    LAS unsigned* rb = (LAS unsigned*)(lds + LDS_BARW - 16);
    if (tid < 2) rb[tid] = 0u;
    __syncthreads();
    if (wave < 4) {
        const float kbA = wave_max(fabsf(a.in[9][lane])) * 8.0f * 1.01f;
        unsigned ep = 0u;
        for (int task = bid; task < DB * 2; task += G) stream_task(a, task, wave, kbA, rb, ep);
    } else {
        peer_topk(a, lds, 4, 4, 0, NTP);
        sample_mixer_b(a, 4, 4);
    }
    __syncthreads();
}
__global__ void __launch_bounds__(NTHREADS, 2) fwd_kernel(Args args) {
    extern __shared__ __attribute__((aligned(16))) unsigned char lds_raw[];
    LAS unsigned char* lds = (LAS unsigned char*)lds_raw;
    const int tid = threadIdx.x;
    if (tid < 8) ((LAS unsigned*)(lds + LDS_BARW - 16))[tid] = 0u;
    __syncthreads();
    const int lo = args.ph_lo, hi = args.ph_hi;
    const bool one = (hi - lo) > 1;
    XcdBarrier bar; bar.bar = (unsigned*)(args.ws + WS_BAR); bar.x = 0; bar.st = nullptr;
    if (one) bar = xcd_barrier_post((unsigned*)(args.ws + WS_BAR), (volatile LAS unsigned*)(lds + LDS_BARW));
#ifndef PH_MASK
#define PH_MASK 1023
#endif
#define IN(k) (((PH_MASK >> (k)) & 1) && lo <= (k) && (k) < hi)
#define SEAM(k) do { if (IN(k) && IN((k) + 1)) xcd_barrier(bar); } while (0)
    unsigned char* ws = args.ws;
    if (IN(0)) p0_prologue(args, lds);
    SEAM(0);
    if (IN(1)) {
        const int G = (int)gridDim.x, GP = (CONV_IN_P1 && G == 256) ? 208 : G;
        if ((int)blockIdx.x < GP) {
            pg8::Gemm g{(const bf16_t*)(ws + WS_XB), (const bf16_t*)(ws + WS_BT1), MT, NQKV, DM}; pg8::StaticOrder S; S.init(MT, NQKV, GP, (int)blockIdx.x);
            EpiQKV E{(const float*)(ws + WS_RSTD1), args.in[8], args.in[9], args.in[10], args.in[11],
                     (bf16_t*)(ws + WS_QA), (bf16_t*)(ws + WS_KA), (bf16_t*)(ws + WS_VAT), (bf16_t*)(ws + WS_QB), (bf16_t*)(ws + WS_KB), (bf16_t*)(ws + WS_VBT), args.out};
            pg8::gemm_phase<EpiQKV, pg8::StaticOrder, true, true>(lds, g, S, E);
        } else tables_fp8(args, ((int)blockIdx.x - GP) * NWAVES + __builtin_amdgcn_readfirstlane(threadIdx.x >> 6), (G - GP) * NWAVES);
    }
    SEAM(1);
    if (IN(2)) p2_attention(args, lds);
    SEAM(2);
#define GEMM_H(ROW0, MROWS, GG, CC) do { pg8::Gemm g{(const bf16_t*)(ws + WS_CAT) + (size_t)(ROW0) * DM, (const bf16_t*)(ws + WS_BT2), (MROWS), DM, DM}; pg8::StaticOrder S; S.init((MROWS), DM, (GG), (CC)); \
        EpiH E{args.in[0], args.in[1], (float*)(ws + WS_H), (bf16_t*)(ws + WS_HB), (float*)(ws + WS_ROWSS), (ROW0)}; \
        pg8::gemm_phase<EpiH, pg8::StaticOrder, true, true>(lds, g, S, E); } while (0)
#define GEMM_S(ROW0, MROWS, GG, CC) do { pg8::Gemm g{(const bf16_t*)(ws + WS_HB) + (size_t)(ROW0) * DM, (const bf16_t*)(ws + WS_BT3), (MROWS), NPQ, DM}; pg8::StaticOrder S; S.init((MROWS), NPQ, (GG), (CC)); \
        EpiS E{(const float*)(ws + WS_ROWSS), (float*)(ws + WS_S), (ROW0)}; \
        pg8::gemm_phase<EpiS, pg8::StaticOrder, true, true>(lds, g, S, E); } while (0)
    if (IN(3)) GEMM_H(0, NTP, (int)gridDim.x, (int)blockIdx.x);
    SEAM(3);
    if (IN(4)) GEMM_S(0, NTP, (int)gridDim.x, (int)blockIdx.x);
    SEAM(4);
    if (IN(5)) p5a_stream_select(args, lds);
    SEAM(5);
    const int wv = __builtin_amdgcn_readfirstlane(threadIdx.x >> 6), NI = (int)gridDim.x >> 3;
    if (IN(6)) {
        constexpr int ND = 2;
        const int cc = (int)blockIdx.x - 8 * (NI - ND);
        if (cc < 0) peer_passA<false>(args, peer_work_plain(wv, NWAVES, NI - ND, 0, NTP));
        else {
            GEMM_H(NTP, NTS, 8 * ND, cc);
            peer_barrier((unsigned*)(ws + WS_BAR), 2, 8u * ND);
            GEMM_S(NTP, NTS, 8 * ND, cc);
        }
    }
    SEAM(6);
    if (IN(7)) { if (wv < 4) peer_coef(args, (int)blockIdx.x * 4 + wv, (int)gridDim.x * 4, 0, NTP); else peer_topk(args, lds, 4, 4, NTP, MT); }
    SEAM(7);
    if (IN(8)) { peer_passB<false>(args, peer_work_plain(wv, NWAVES, NI, 0, NTP)); peer_passA<false>(args, peer_work_plain(wv, NWAVES, NI, NTP, MT)); }
    SEAM(8);
    if (IN(9)) {
        for (int t = NTP + (int)(blockIdx.x >> 3) + NI * wv; t < MT; t += NI * NWAVES) peer_coef(args, 0, 1, t, t + 1);
        asm volatile("s_waitcnt vmcnt(0)" ::: "memory");
        __syncthreads();
        peer_passB<false>(args, peer_work_plain(wv, NWAVES, NI, NTP, MT));
    }

#undef IN
#undef SEAM
}

extern "C" void kernel_launch(void* const* d_in, const int* in_sizes, int n_in, void* d_out, int out_size, void* d_ws, size_t ws_size, hipStream_t stream) {
    static int grid = 0;
    if (grid == 0) {
        if (n_in != 19 || (size_t)out_size != O_END || ws_size < WS_END) { fprintf(stderr, "kernel_launch: unexpected shapes (n_in %d out %d ws %zu)\n", n_in, out_size, ws_size); grid = -1; return; }
        int dev = 0, cus = 0, per_cu = 0;
        if (hipGetDevice(&dev) != hipSuccess || hipDeviceGetAttribute(&cus, hipDeviceAttributeMultiprocessorCount, dev) != hipSuccess) { grid = -1; return; }
        if (hipFuncSetAttribute((const void*)fwd_kernel, hipFuncAttributeMaxDynamicSharedMemorySize, LDS_BYTES) != hipSuccess) { fprintf(stderr, "kernel_launch: hipFuncSetAttribute failed\n"); grid = -1; return; }
        if (hipOccupancyMaxActiveBlocksPerMultiprocessor(&per_cu, (const void*)fwd_kernel, NTHREADS, LDS_BYTES) != hipSuccess || per_cu < 1) { fprintf(stderr, "kernel_launch: occupancy query says %d\n", per_cu); }
        (void)hipGetLastError();
        if (cus < 32 || (cus & 7)) { fprintf(stderr, "kernel_launch: %d CUs\n", cus); grid = -1; return; }
        grid = cus;
    }
    if (grid < 0) return;
    (void)hipMemsetAsync((char*)d_ws + WS_BAR, 0, WS_ZERO_BYTES, stream);
    Args a{};
    for (int i = 0; i < 19; ++i) a.in[i] = (const float*)d_in[i];
    a.out = (float*)d_out; a.ws = (unsigned char*)d_ws;
#if N_LAUNCHES == 1
    a.ph_lo = 0; a.ph_hi = 10;
    hipLaunchKernelGGL(fwd_kernel, dim3(grid), dim3(NTHREADS), LDS_BYTES, stream, a);
#else
    for (int p = 0; p < 10; ++p) { a.ph_lo = p; a.ph_hi = p + 1; hipLaunchKernelGGL(fwd_kernel, dim3(grid), dim3(NTHREADS), LDS_BYTES, stream, a); }
#endif
}
```

```cpp
#include <hip/hip_runtime.h>
#include <cstdio>
#include <cstdint>

#ifndef PEER_SCALE
#define PEER_SCALE 1.0f
#endif
#ifndef SB
#define SB 4
#endif
#ifndef CONV_IN_P1
#define CONV_IN_P1 1
#endif
#ifndef N_LAUNCHES
#define N_LAUNCHES 1
#endif

namespace pg8 {
#define PG8_LAS __attribute__((address_space(3)))
typedef unsigned short bf16_t;
typedef short bf16x8 __attribute__((ext_vector_type(8)));
typedef float f32x4 __attribute__((ext_vector_type(4)));
typedef unsigned u32x4 __attribute__((ext_vector_type(4)));
constexpr int BM = 256, BK = 64, HALF = 128, HTB = HALF * BK * 2  , STAGE_BYTES = 8 * HTB, NXCD = 8, WGM = 8;

__host__ __device__ __forceinline__ int lds_byte(int r, int c) { const int st = (r >> 4) * 2 + (c >> 5), rr = r & 15, cc = c & 31, ob = rr * 64 + cc * 2; return st * 1024 + (ob ^ (((ob >> 9) & 1) << 5)); }
__host__ __device__ __forceinline__ void stage_rc(int b, int& R, int& C) { const int st = b / 1024, sb = b % 1024, swz = sb ^ (((sb >> 9) & 1) << 5); R = (st >> 1) * 16 + swz / 64; C = (st & 1) * 32 + (swz % 64) / 2; }
__host__ __device__ __forceinline__ int perm32(int rho) { const int n = rho >> 4, i = rho & 15; return 8 * (i >> 2) + 4 * n + (i & 3); }

struct Unit { int pm, pn; };
struct Gemm { const bf16_t* A; const bf16_t* Bt; int M, N, K; };

struct StaticOrder {
    int nM, nN, nwg, G, c;
    __host__ __device__ void init(int M, int N, int G_, int c_) { nM = M / BM; nN = N / BM; nwg = nM * nN; G = G_; c = c_; }
    __host__ __device__ bool next(int i, Unit& u) const {
        const long L = (long)i * G + c; if (L >= nwg) return false;
        int wgid = (int)L; { const int q = nwg / NXCD, r = nwg % NXCD, xcd = wgid % NXCD, off = wgid / NXCD; wgid = (xcd < r ? xcd * (q + 1) : r * (q + 1) + (xcd - r) * q) + off; }
        const int nig = WGM * nN, gid = wgid / nig, fm = gid * WGM, gsz = (nM - fm) < WGM ? (nM - fm) : WGM;
        u.pm = fm + ((wgid % nig) % gsz); u.pn = (wgid % nig) / gsz; return true;
    }

    __device__ __forceinline__ void a_ready(const Unit&) const {}
    __device__ __forceinline__ void done(const Unit&) const {}
};
__device__ __forceinline__ unsigned cvt_pk_bf16(float lo, float hi) { unsigned r; asm volatile("v_cvt_pk_bf16_f32 %0, %1, %2" : "=v"(r) : "v"(lo), "v"(hi)); return r; }
template <class Epi, class Sched, bool ALIGN_EPI = false, bool SP2 = false>
__device__ __forceinline__ void gemm_phase(PG8_LAS unsigned char* lds, const Gemm g, const Sched& S, const Epi& E) {
    const int tid = threadIdx.x, wid = __builtin_amdgcn_readfirstlane(tid >> 6), lane = tid & 63, wr = wid >> 2, wc = wid & 3, fr = lane & 15, fq = lane >> 4;
    const int K = g.K, nt = K / BK;
    unsigned voffA[2], voffB[2];
#pragma unroll
    for (int i = 0; i < 2; ++i) { int R, C; stage_rc(tid * 16 + i * 8192, R, C); const int Rb = Epi::PERM ? ((R & ~31) + perm32(R & 31)) : R;
        voffA[i] = (unsigned)(R * K + C) * 2u; voffB[i] = (unsigned)(Rb * K + C) * 2u; }
    const size_t kstep = (size_t)(BK * 2);
    const size_t hstep = (size_t)HALF * K * 2;
    const size_t tstep = 2 * hstep;
    const unsigned ldsw = (unsigned)wid * 1024u;
    const int aoff = lds_byte(wr * 64 + fr, fq * 8), boff = lds_byte(wc * 32 + fr, fq * 8);
#define PG8_SA(b, h) (((b) * 2 + (h)) * HTB)
#define PG8_SB(b, h) ((4 + (b) * 2 + (h)) * HTB)
#define PG8_STAGE(bufoff, gbase, voff) do { _Pragma("unroll") for (int _i = 0; _i < 2; ++_i) \
        __builtin_amdgcn_global_load_lds((const unsigned*)((const char*)(gbase) + (voff)[_i]), (PG8_LAS unsigned*)(lds + (bufoff) + ldsw + _i * 8192), 16, 0, 0); } while (0)
#define PG8_LDA(dst, b, h) do { _Pragma("unroll") for (int m = 0; m < 4; ++m) _Pragma("unroll") for (int k = 0; k < 2; ++k) dst[m][k] = *(const PG8_LAS bf16x8*)(lds + PG8_SA(b, h) + aoff + m * 2048 + k * 1024); } while (0)
#define PG8_LDB(dst, b, h) do { _Pragma("unroll") for (int n = 0; n < 2; ++n) _Pragma("unroll") for (int k = 0; k < 2; ++k) dst[n][k] = *(const PG8_LAS bf16x8*)(lds + PG8_SB(b, h) + boff + n * 2048 + k * 1024); } while (0)
#define PG8_MMA(ai, bj, At, Bt) do { __builtin_amdgcn_s_setprio(1); _Pragma("unroll") for (int m = 0; m < 4; ++m) _Pragma("unroll") for (int n = 0; n < 2; ++n) _Pragma("unroll") for (int k = 0; k < 2; ++k) \
        acc[ai][bj][m][n] = __builtin_amdgcn_mfma_f32_16x16x32_bf16(Bt[n][k], At[m][k], acc[ai][bj][m][n], 0, 0, 0); __builtin_amdgcn_s_setprio(0); } while (0)
#define PG8_WAIT_V(n) asm volatile("s_waitcnt vmcnt(" #n ")" ::: "memory")
#define PG8_WAIT_L(n) asm volatile("s_waitcnt lgkmcnt(" #n ")" ::: "memory")
#define PG8_BAR __builtin_amdgcn_s_barrier()
#define PG8_SCHED __builtin_amdgcn_sched_barrier(0)
    Unit cur, nxt; int ui = 0;
    if (!S.next(0, cur)) return;
    f32x4 acc[2][2][4][2];
    if constexpr (Epi::INIT_ACC) E.init(acc, cur, wr, wc, fr, fq);
    else {
#pragma unroll
    for (int a = 0; a < 2; ++a)
#pragma unroll
        for (int b = 0; b < 2; ++b)
#pragma unroll
            for (int m = 0; m < 4; ++m)
#pragma unroll
                for (int n = 0; n < 2; ++n) acc[a][b][m][n] = (f32x4){0.f, 0.f, 0.f, 0.f};
    }
    bf16x8 At[4][2], B0[2][2], B1[2][2];
    const char* cA = (const char*)g.A + (size_t)cur.pm * tstep; const char* cB = (const char*)g.Bt + (size_t)cur.pn * tstep;
    S.a_ready(cur);
    if constexpr (SP2) {
        PG8_STAGE(PG8_SB(0, 0), cB, voffB); PG8_STAGE(PG8_SB(0, 1), cB + hstep, voffB); PG8_STAGE(PG8_SA(0, 0), cA, voffA); PG8_STAGE(PG8_SA(0, 1), cA + hstep, voffA);
        if (wr == 1) PG8_BAR;
        PG8_WAIT_V(2); PG8_BAR;
        PG8_STAGE(PG8_SB(1, 0), cB + kstep, voffB); PG8_STAGE(PG8_SA(1, 0), cA + kstep, voffA); PG8_STAGE(PG8_SB(1, 1), cB + hstep + kstep, voffB);
        PG8_WAIT_V(6); PG8_BAR;
    } else {
        PG8_STAGE(PG8_SB(0, 0), cB, voffB); PG8_STAGE(PG8_SA(0, 0), cA, voffA); PG8_STAGE(PG8_SB(0, 1), cB + hstep, voffB); PG8_STAGE(PG8_SA(0, 1), cA + hstep, voffA);
        if (wr == 1) PG8_BAR;
        PG8_WAIT_V(4); PG8_BAR;
        PG8_STAGE(PG8_SB(1, 0), cB + kstep, voffB); PG8_STAGE(PG8_SA(1, 0), cA + kstep, voffA); PG8_STAGE(PG8_SB(1, 1), cB + hstep + kstep, voffB);
        PG8_WAIT_V(6); PG8_BAR;
    }
    for (;;) {
        const bool has_next = S.next(ui + 1, nxt);
        const char* nA = has_next ? (const char*)g.A + (size_t)nxt.pm * tstep : cA; const char* nB = has_next ? (const char*)g.Bt + (size_t)nxt.pn * tstep : cB;
        for (int t = 0; t < nt; t += 2) {
            const bool last = (t == nt - 2);
            const char* a1 = cA + (size_t)(t + 1) * kstep;
            const char* a2 = last ? nA : cA + (size_t)(t + 2) * kstep; const char* b2 = last ? nB : cB + (size_t)(t + 2) * kstep;
            const char* a3 = a2 + kstep; const char* b3 = b2 + kstep;
            if (last && has_next) S.a_ready(nxt);
            if constexpr (SP2) {
            PG8_LDB(B0, 0, 0); PG8_LDB(B1, 0, 1); PG8_SCHED; PG8_LDA(At, 0, 0); PG8_STAGE(PG8_SA(1, 1), a1 + hstep, voffA);
            PG8_WAIT_V(8); PG8_WAIT_L(0); PG8_BAR; PG8_MMA(0, 0, At, B0); PG8_MMA(0, 1, At, B1); PG8_BAR; PG8_SCHED;
            PG8_LDA(At, 0, 1); PG8_STAGE(PG8_SB(0, 0), b2, voffB); PG8_STAGE(PG8_SB(0, 1), b2 + hstep, voffB); PG8_STAGE(PG8_SA(0, 0), a2, voffA);
            PG8_WAIT_V(8); PG8_WAIT_L(0); PG8_BAR; PG8_MMA(1, 0, At, B0); PG8_MMA(1, 1, At, B1); PG8_BAR; PG8_SCHED;
            PG8_LDB(B0, 1, 0); PG8_LDB(B1, 1, 1); PG8_SCHED; PG8_LDA(At, 1, 0); PG8_STAGE(PG8_SA(0, 1), a2 + hstep, voffA);
            PG8_WAIT_V(8); PG8_WAIT_L(0); PG8_BAR; PG8_MMA(0, 0, At, B0); PG8_MMA(0, 1, At, B1); PG8_BAR; PG8_SCHED;
            PG8_LDA(At, 1, 1); PG8_STAGE(PG8_SB(1, 0), b3, voffB); PG8_STAGE(PG8_SB(1, 1), b3 + hstep, voffB); PG8_STAGE(PG8_SA(1, 0), a3, voffA);
            PG8_WAIT_V(8); PG8_WAIT_L(0); PG8_BAR; PG8_MMA(1, 0, At, B0); PG8_MMA(1, 1, At, B1); PG8_BAR; PG8_SCHED;
            } else {
            PG8_LDB(B0, 0, 0); PG8_SCHED; PG8_LDA(At, 0, 0); PG8_STAGE(PG8_SA(1, 1), a1 + hstep, voffA);
            PG8_WAIT_L(8); PG8_BAR; PG8_WAIT_L(0); PG8_MMA(0, 0, At, B0); PG8_BAR; PG8_SCHED;
            PG8_LDB(B1, 0, 1); PG8_STAGE(PG8_SB(0, 0), b2, voffB);
            PG8_BAR; PG8_WAIT_L(0); PG8_MMA(0, 1, At, B1); PG8_BAR;
            PG8_LDA(At, 0, 1); PG8_STAGE(PG8_SA(0, 0), a2, voffA);
            PG8_BAR; PG8_WAIT_L(0); PG8_MMA(1, 0, At, B0); PG8_BAR; PG8_SCHED;
            PG8_STAGE(PG8_SB(0, 1), b2 + hstep, voffB);
            PG8_WAIT_V(6); PG8_BAR; PG8_MMA(1, 1, At, B1); PG8_BAR;
            PG8_LDB(B0, 1, 0); PG8_SCHED; PG8_LDA(At, 1, 0); PG8_STAGE(PG8_SA(0, 1), a2 + hstep, voffA);
            PG8_WAIT_L(8); PG8_BAR; PG8_WAIT_L(0); PG8_MMA(0, 0, At, B0); PG8_BAR; PG8_SCHED;
            PG8_LDB(B1, 1, 1); PG8_STAGE(PG8_SB(1, 0), b3, voffB);
            PG8_BAR; PG8_WAIT_L(0); PG8_MMA(0, 1, At, B1); PG8_BAR;
            PG8_LDA(At, 1, 1); PG8_STAGE(PG8_SA(1, 0), a3, voffA);
            PG8_BAR; PG8_WAIT_L(0); PG8_MMA(1, 0, At, B0); PG8_BAR; PG8_SCHED;
            PG8_STAGE(PG8_SB(1, 1), b3 + hstep, voffB);
            PG8_WAIT_V(6); PG8_BAR; PG8_MMA(1, 1, At, B1); PG8_BAR;
            }
        }
        if constexpr (ALIGN_EPI) { if (wr == 0) PG8_BAR; }
        if constexpr (!Epi::AFTER_DRAIN) { E(acc, cur, wr, wc, fr, fq); S.done(cur); }
        if (!has_next) break;
        if constexpr (Epi::INIT_ACC) E.init(acc, nxt, wr, wc, fr, fq);
        else {
#pragma unroll
        for (int a = 0; a < 2; ++a)
#pragma unroll
            for (int b = 0; b < 2; ++b)
#pragma unroll
                for (int m = 0; m < 4; ++m)
#pragma unroll
                    for (int n = 0; n < 2; ++n) acc[a][b][m][n] = (f32x4){0.f, 0.f, 0.f, 0.f};
        }
        cur = nxt; cA = nA; cB = nB; ++ui;
        if constexpr (ALIGN_EPI) { if (wr == 1) PG8_BAR; }
    }
    PG8_WAIT_V(0);
    if constexpr (!ALIGN_EPI) { if (wr == 0) PG8_BAR; }
    PG8_BAR;
    if constexpr (Epi::AFTER_DRAIN) { E.fused(acc, cur, wr, wc, fr, fq, lds, wid, lane); S.done(cur); }
#undef PG8_SA
#undef PG8_SB
#undef PG8_STAGE
#undef PG8_LDA
#undef PG8_LDB
#undef PG8_MMA
#undef PG8_WAIT_V
#undef PG8_WAIT_L
#undef PG8_BAR
#undef PG8_SCHED
}
}

#define XB_TMO      128
#define XB_XCNT(j)  (256  + 64 * (j))
#define XB_XSUB(j)  (1280 + 64 * (j))
#define XB_XGEN(j)  (2304 + 64 * (j))
#define XB_TOP      3328
#define XB_TOPGEN   3392
#define XCD_BAR_WORDS 3456
#define XB_SPIN_CAP (1u << 18)
#define LAS __attribute__((address_space(3)))

__device__ __forceinline__ unsigned xb_ld(unsigned* p)              { return __hip_atomic_load(p, __ATOMIC_RELAXED, __HIP_MEMORY_SCOPE_AGENT); }
__device__ __forceinline__ unsigned xb_add(unsigned* p, unsigned v) { return __hip_atomic_fetch_add(p, v, __ATOMIC_RELAXED, __HIP_MEMORY_SCOPE_AGENT); }
__device__ __forceinline__ unsigned xb_xcc_id() { return (unsigned)__builtin_amdgcn_s_getreg((3 << 11) | 20) & 0xFu; }
#define XB_SPIN(cond, bar) do { unsigned _sp = 0; while (cond) { __builtin_amdgcn_s_sleep(1); \
    if ((++_sp & 255u) == 0u) { if (xb_ld(&(bar)[XB_TMO])) break; if (_sp > XB_SPIN_CAP) { atomicAdd(&(bar)[XB_TMO], 1u); break; } } } } while (0)

struct XcdBarrier {
    unsigned* bar; unsigned x;
    volatile LAS unsigned* st;
};

__device__ __forceinline__ XcdBarrier xcd_barrier_post(unsigned* bar, volatile LAS unsigned* st) {
    XcdBarrier b; b.bar = bar; b.x = xb_xcc_id(); b.st = st;
    if (threadIdx.x == 0) (void)xb_add(&bar[XB_XCNT(b.x)], 1u);
    return b;
}
__device__ __forceinline__ void xcd_barrier_complete(unsigned* bar, unsigned x, unsigned& nloc, unsigned& nx) {
    const unsigned G = gridDim.x * gridDim.y * gridDim.z;
    unsigned sum, cnt, mine, sp = 0u;
    for (;;) {
        sum = 0u; cnt = 0u; mine = 0u;
#pragma unroll
        for (unsigned j = 0; j < 16; ++j) { const unsigned c = xb_ld(&bar[XB_XCNT(j)]); sum += c; cnt += (c > 0u) ? 1u : 0u; mine = (j == x) ? c : mine; }
        if (sum == G) break;
        __builtin_amdgcn_s_sleep(1);
        if ((++sp & 255u) == 0u) { if (xb_ld(&bar[XB_TMO])) break; if (sp > XB_SPIN_CAP) { atomicAdd(&bar[XB_TMO], 1u); break; } }
    }
    nloc = mine > 0u ? mine : 1u; nx = cnt > 0u ? cnt : 1u;
}

__device__ __forceinline__ void xcd_barrier(const XcdBarrier& b) {
    asm volatile("s_waitcnt vmcnt(0)" ::: "memory");
    __syncthreads();
    if (threadIdx.x == 0) {
        unsigned* bar = b.bar;
        __builtin_amdgcn_s_waitcnt(0);
        unsigned nloc = b.st[0], nx = b.st[1];
        if (nloc == 0u) { xcd_barrier_complete(bar, b.x, nloc, nx); b.st[0] = nloc; b.st[1] = nx; }
        const unsigned old = xb_add(&bar[XB_XSUB(b.x)], 1u);
        const unsigned gen = old / nloc;
        if (old + 1u == (gen + 1u) * nloc) {
            __builtin_amdgcn_fence(__ATOMIC_RELEASE, "agent");
            asm volatile("s_waitcnt vmcnt(0)" ::: "memory");
            const unsigned og = xb_add(&bar[XB_TOP], 1u);
            const unsigned tg = og / nx;
            if (og + 1u == (tg + 1u) * nx) xb_add(&bar[XB_TOPGEN], 1u);
            else XB_SPIN(xb_ld(&bar[XB_TOPGEN]) == tg, bar);
            __builtin_amdgcn_fence(__ATOMIC_ACQUIRE, "agent");
            xb_add(&bar[XB_XGEN(b.x)], 1u);
            asm volatile("s_waitcnt vmcnt(0)" ::: "memory");
        } else {
            XB_SPIN(xb_ld(&bar[XB_XGEN(b.x)]) == gen, bar);
            __builtin_amdgcn_fence(__ATOMIC_ACQUIRE, "agent");
            asm volatile("s_waitcnt vmcnt(0)" ::: "memory");
        }
    }
    __syncthreads();
}

using pg8::bf16_t; using pg8::bf16x8; using pg8::f32x4; using pg8::u32x4; using pg8::cvt_pk_bf16;
typedef float f32x16 __attribute__((ext_vector_type(16)));
typedef unsigned u32x2 __attribute__((ext_vector_type(2)));

constexpr int DM = 1024, NB = 4, SEQ = 4096, NTP = NB * SEQ, DB = 128, DS = 8, NTS = DB * DS, MT = NTP + NTS;
constexpr int LA = 2048, LBW = 128, NQKV = 2304, NPQ = 2048, NEXP = 16384;
constexpr float EPS = 1e-6f, LOG2E = 1.4426950408889634f, QSCALE = 0.125f * LOG2E;
constexpr int NTHREADS = 512, NWAVES = 8;
constexpr int LDS_BYTES = 158720;
constexpr int LDS_BARW = LDS_BYTES - 16;

constexpr size_t O_YP = 0, O_YS = 16777216, O_AKP = 17825792, O_AVP = 22020096, O_BKP = 26214400, O_BVP = 26279936,
                 O_AKS = 26345472, O_AVS = 160563200, O_BKS = 294780928, O_BVS = 296878080, O_END = 298975232;

constexpr size_t WS_BAR = 0, WS_ROWSS = 16384, WS_ZERO_BYTES = WS_ROWSS + (size_t)MT * 4;
constexpr size_t WS_RSTD1 = WS_ZERO_BYTES;
constexpr size_t WS_XB  = WS_RSTD1 + (size_t)MT * 4;
constexpr size_t WS_BT1 = WS_XB + (size_t)MT * DM * 2;
constexpr size_t WS_BT2 = WS_BT1 + (size_t)NQKV * DM * 2;
constexpr size_t WS_BT3 = WS_BT2 + (size_t)DM * DM * 2;
constexpr size_t WS_U8  = WS_BT3 + (size_t)NPQ * DM * 2;
constexpr size_t WS_V8  = WS_U8 + (size_t)NEXP * DM;
constexpr size_t WS_USC = WS_V8 + (size_t)NEXP * DM;
constexpr size_t WS_VSC = WS_USC + (size_t)NEXP * 4;
constexpr size_t WS_QA  = WS_VSC + (size_t)NEXP * 4;
constexpr size_t WS_KA  = WS_QA + (size_t)MT * 512 * 2;
constexpr size_t WS_VAT = WS_KA + (size_t)MT * 512 * 2;
constexpr size_t WS_QB  = WS_VAT + (size_t)MT * 512 * 2;
constexpr size_t WS_KB  = WS_QB + (size_t)MT * 512 * 2;
constexpr size_t WS_VBT = WS_KB + (size_t)MT * 128 * 2;
constexpr size_t WS_CAT = WS_VBT + (size_t)MT * 128 * 2;
constexpr size_t WS_H   = WS_CAT + (size_t)MT * DM * 2;
constexpr size_t WS_HB  = WS_H + (size_t)MT * DM * 4;
constexpr size_t WS_S   = WS_HB + (size_t)MT * DM * 2;
constexpr size_t WS_SPART = WS_S + (size_t)MT * NPQ * 4;
constexpr size_t WS_PEERK = WS_SPART + (size_t)DB * 2 * 40960;
constexpr size_t WS_PD = WS_PEERK + (size_t)MT * 1024;
constexpr size_t WS_COEF = WS_PD + (size_t)MT * 4096;
constexpr size_t WS_END = WS_COEF + (size_t)MT * 512;
constexpr size_t SLICE_BYTES = (size_t)NEXP * 128;
static_assert(WS_RSTD1 % 256 == 0 && WS_XB % 256 == 0 && WS_BT1 % 256 == 0 && WS_S % 256 == 0 && WS_PEERK % 256 == 0 && WS_PD % 256 == 0 && WS_U8 % 256 == 0, "alignment");

struct Args { const float* in[19]; float* out; unsigned char* ws; int ph_lo, ph_hi; };

__device__ __forceinline__ float wave_sum(float v) {
#pragma unroll
    for (int o = 32; o >= 1; o >>= 1) v += __shfl_xor(v, o);
    return v;
}
__device__ __forceinline__ float wave_max(float v) {
#pragma unroll
    for (int o = 32; o >= 1; o >>= 1) v = fmaxf(v, __shfl_xor(v, o));
    return v;
}
__device__ __forceinline__ float readlane_f(float v, int l) { return __uint_as_float((unsigned)__builtin_amdgcn_readlane((int)__float_as_uint(v), l)); }
__device__ __forceinline__ float bf_lo(unsigned w) { return __uint_as_float(w << 16); }
__device__ __forceinline__ float bf_hi(unsigned w) { return __uint_as_float(w & 0xffff0000u); }
__device__ __forceinline__ float alibi_slope(int h) { return exp2f(-(float)(h + 1)); }

__device__ __forceinline__ void late_prologue(const Args& a, LAS unsigned char* lds, LAS unsigned* rbc, unsigned& ep, const int aw);
__device__ __forceinline__ void p0_prologue(const Args& a, LAS unsigned char* lds) {
    const int tid = threadIdx.x, lane = tid & 63, wave = tid >> 6, G = gridDim.x, bid = blockIdx.x;
    unsigned char* ws = a.ws;
    {
        bf16_t* XB = (bf16_t*)(ws + WS_XB); float* rstd = (float*)(ws + WS_RSTD1);
        const int NWX = (CONV_IN_P1 && G == 256) ? 4 : NWAVES;
        const int rstep = G * NWX;
        int row = bid * NWX + wave;
        if (wave < NWX) {
        f32x4 v[4];
        if (row < MT) { const float* x = row < NTP ? a.in[0] + (size_t)row * DM : a.in[1] + (size_t)(row - NTP) * DM;
#pragma unroll
            for (int k = 0; k < 4; ++k) v[k] = *(const f32x4*)(x + k * 256 + lane * 4); }
        for (; row < MT; row += rstep) {
            f32x4 vn[4];
            { const int rn = min(row + rstep, MT - 1); const float* x = rn < NTP ? a.in[0] + (size_t)rn * DM : a.in[1] + (size_t)(rn - NTP) * DM;
#pragma unroll
              for (int k = 0; k < 4; ++k) vn[k] = *(const f32x4*)(x + k * 256 + lane * 4); }
            float ss = 0.f;
#pragma unroll
            for (int k = 0; k < 4; ++k) ss += v[k][0] * v[k][0] + v[k][1] * v[k][1] + v[k][2] * v[k][2] + v[k][3] * v[k][3];
            ss = wave_sum(ss);
            if (lane == 0) rstd[row] = rsqrtf(ss * (1.0f / DM) + EPS);
#pragma unroll
            for (int k = 0; k < 4; ++k) { u32x2 w; w.x = cvt_pk_bf16(v[k][0], v[k][1]); w.y = cvt_pk_bf16(v[k][2], v[k][3]); *(u32x2*)(XB + (size_t)row * DM + k * 256 + lane * 4) = w; }
#pragma unroll
            for (int k = 0; k < 4; ++k) v[k] = vn[k];
        }
        } else { unsigned ep = 0u; late_prologue(a, lds, (LAS unsigned*)(lds + LDS_BARW - 16) + 1, ep, wave - 4); }
        __syncthreads();
    }
    {
        LAS float* T = (LAS float*)lds;
        bf16_t* BT1 = (bf16_t*)(ws + WS_BT1); bf16_t* BT2 = (bf16_t*)(ws + WS_BT2);
        const int nt1 = (NQKV / 64) * 16, nt2 = 0;
        for (int t = bid; t < nt1 + nt2; t += G) {
            const bool first = t < nt1; const int t2 = first ? t : t - nt1;
            const int ct = t2 >> 4, dt = t2 & 15;
            const float* W = first ? a.in[7] : a.in[13]; const int ldw = first ? NQKV : DM; bf16_t* BT = first ? BT1 : BT2;
            const int ty = tid >> 6, tx = tid & 63;
#pragma unroll
            for (int k = 0; k < 8; ++k) { const int dd = ty + 8 * k; float w = W[(size_t)(dt * 64 + dd) * ldw + ct * 64 + tx]; if (first) w *= a.in[6][dt * 64 + dd]; T[dd * 65 + tx] = w; }
            __syncthreads();
            const int cc = tid >> 3, dsg = tid & 7, c = ct * 64 + cc;
            const int memrow = first ? (c & ~255) + ((c & 63) >> 5) * 128 + ((c & 255) >> 6) * 32 + (c & 31) : c;
            u32x4 w; w.x = cvt_pk_bf16(T[(8 * dsg + 0) * 65 + cc], T[(8 * dsg + 1) * 65 + cc]); w.y = cvt_pk_bf16(T[(8 * dsg + 2) * 65 + cc], T[(8 * dsg + 3) * 65 + cc]);
            w.z = cvt_pk_bf16(T[(8 * dsg + 4) * 65 + cc], T[(8 * dsg + 5) * 65 + cc]); w.w = cvt_pk_bf16(T[(8 * dsg + 6) * 65 + cc], T[(8 * dsg + 7) * 65 + cc]);
            *(u32x4*)(BT + (size_t)memrow * DM + dt * 64 + 8 * dsg) = w;
            __syncthreads();
        }
    }
}

struct EpiQKV {
    static constexpr bool PERM = true, AFTER_DRAIN = false, INIT_ACC = false;
    const float* rstd; const float* gqa; const float* gka; const float* gqb; const float* gkb;
    bf16_t* QA; bf16_t* KA; bf16_t* VAT; bf16_t* QB; bf16_t* KB; bf16_t* VBT; float* out;
    __device__ __forceinline__ void operator()(const f32x4 (&acc)[2][2][4][2], const pg8::Unit& u, int wr, int wc, int fr, int fq) const {
        const int hd = u.pn * 4 + wc;
        const int type = hd < 8 ? 0 : hd < 16 ? 1 : hd < 24 ? 2 : hd < 32 ? 3 : hd < 34 ? 4 : 5;
        const int hl = type == 0 ? hd : type == 1 ? hd - 8 : type == 2 ? hd - 16 : type == 3 ? hd - 24 : type == 4 ? hd - 32 : hd - 34;
        const float* gv = type == 0 ? gqa : type == 1 ? gka : type == 3 ? gqb : type == 4 ? gkb : nullptr;
        const float qs = (type == 0 || type == 3) ? QSCALE : 1.0f;
        f32x4 gg[2][2];
#pragma unroll
        for (int bj = 0; bj < 2; ++bj)
#pragma unroll
            for (int n = 0; n < 2; ++n) gg[bj][n] = gv ? *(const f32x4*)(gv + 32 * bj + 8 * fq + 4 * n) : (f32x4){1.f, 1.f, 1.f, 1.f};
#pragma unroll
        for (int ai = 0; ai < 2; ++ai)
#pragma unroll
            for (int m = 0; m < 4; ++m) {
                const int row = u.pm * 256 + ai * 128 + wr * 64 + m * 16 + fr;
                const float rs = rstd[row];
                f32x4 v[2][2]; float ss = 0.f;
#pragma unroll
                for (int bj = 0; bj < 2; ++bj)
#pragma unroll
                    for (int n = 0; n < 2; ++n) { v[bj][n] = acc[ai][bj][m][n] * rs; ss += v[bj][n][0] * v[bj][n][0] + v[bj][n][1] * v[bj][n][1] + v[bj][n][2] * v[bj][n][2] + v[bj][n][3] * v[bj][n][3]; }
                if (gv) {
                    ss += __shfl_xor(ss, 16); ss += __shfl_xor(ss, 32);
                    const float rn = rsqrtf(ss * (1.0f / 64.0f) + EPS) * qs;
#pragma unroll
                    for (int bj = 0; bj < 2; ++bj)
#pragma unroll
                        for (int n = 0; n < 2; ++n) v[bj][n] = v[bj][n] * rn * gg[bj][n];
                }
                const bool samp = row >= NTP;
                const int b = samp ? (row - NTP) >> 3 : row >> 12, pos = samp ? (row - NTP) & 7 : row & 4095;
                u32x4 pk[2];
#pragma unroll
                for (int bj = 0; bj < 2; ++bj) { pk[bj].x = cvt_pk_bf16(v[bj][0][0], v[bj][0][1]); pk[bj].y = cvt_pk_bf16(v[bj][0][2], v[bj][0][3]); pk[bj].z = cvt_pk_bf16(v[bj][1][0], v[bj][1][1]); pk[bj].w = cvt_pk_bf16(v[bj][1][2], v[bj][1][3]); }
                if (type == 0 || type == 3) {
                    bf16_t* dst = (type == 0 ? QA : QB) + (size_t)row * 512 + hl * 64 + 8 * fq;
                    *(u32x4*)dst = pk[0]; *(u32x4*)(dst + 32) = pk[1];
                } else if (type == 1 || type == 4) {
                    bf16_t* dst = type == 1 ? KA + (size_t)row * 512 + hl * 64 + 8 * fq : KB + (size_t)row * 128 + hl * 64 + 8 * fq;
                    *(u32x4*)dst = pk[0]; *(u32x4*)(dst + 32) = pk[1];
                    float* fo = nullptr;
                    if (type == 1) { if (samp) fo = out + O_AKS + ((size_t)(b * LA + LA - DS + pos) * 8 + hl) * 64; else if (pos >= SEQ - LA) fo = out + O_AKP + ((size_t)(b * LA + pos - (SEQ - LA)) * 8 + hl) * 64; }
                    else { if (samp) fo = out + O_BKS + ((size_t)(b * LBW + LBW - DS + pos) * 2 + hl) * 64; else if (pos >= SEQ - LBW) fo = out + O_BKP + ((size_t)(b * LBW + pos - (SEQ - LBW)) * 2 + hl) * 64; }
                    if (fo) {
#pragma unroll
                        for (int bj = 0; bj < 2; ++bj)
#pragma unroll
                            for (int n = 0; n < 2; ++n) *(f32x4*)(fo + 32 * bj + 8 * fq + 4 * n) = v[bj][n];
                    }
                } else {
                    bf16_t* dst = type == 2 ? VAT + (size_t)row * 512 + hl * 64 + 8 * fq : VBT + (size_t)row * 128 + hl * 64 + 8 * fq;
                    *(u32x4*)dst = pk[0]; *(u32x4*)(dst + 32) = pk[1];
                    float* fo = nullptr;
                    if (type == 2) { if (samp) fo = out + O_AVS + ((size_t)(b * LA + LA - DS + pos) * 8 + hl) * 64; else if (pos >= SEQ - LA) fo = out + O_AVP + ((size_t)(b * LA + pos - (SEQ - LA)) * 8 + hl) * 64; }
                    else { if (samp) fo = out + O_BVS + ((size_t)(b * LBW + LBW - DS + pos) * 2 + hl) * 64; else if (pos >= SEQ - LBW) fo = out + O_BVP + ((size_t)(b * LBW + pos - (SEQ - LBW)) * 2 + hl) * 64; }
                    if (fo) {
#pragma unroll
                        for (int bj = 0; bj < 2; ++bj)
#pragma unroll
                            for (int n = 0; n < 2; ++n) *(f32x4*)(fo + 32 * bj + 8 * fq + 4 * n) = v[bj][n];
                    }
                }
            }
    }
};
struct EpiH {
    static constexpr bool PERM = false, AFTER_DRAIN = false, INIT_ACC = true;
    const float* x0; const float* x1; float* H; bf16_t* HB; float* rowss; int row0;
    __device__ __forceinline__ void init(f32x4 (&acc)[2][2][4][2], const pg8::Unit& u, int wr, int wc, int fr, int fq) const {
#pragma unroll
        for (int ai = 0; ai < 2; ++ai)
#pragma unroll
            for (int m = 0; m < 4; ++m) {
                const int row = row0 + u.pm * 256 + ai * 128 + wr * 64 + m * 16 + fr;
                const float* xr = row < NTP ? x0 + (size_t)row * DM : x1 + (size_t)(row - NTP) * DM;
#pragma unroll
                for (int bj = 0; bj < 2; ++bj)
#pragma unroll
                    for (int n = 0; n < 2; ++n) acc[ai][bj][m][n] = *(const f32x4*)(xr + u.pn * 256 + bj * 128 + wc * 32 + n * 16 + 4 * fq);
            }
    }
    __device__ __forceinline__ void operator()(const f32x4 (&acc)[2][2][4][2], const pg8::Unit& u, int wr, int wc, int fr, int fq) const {
#pragma unroll
        for (int ai = 0; ai < 2; ++ai)
#pragma unroll
            for (int m = 0; m < 4; ++m) {
                const int row = row0 + u.pm * 256 + ai * 128 + wr * 64 + m * 16 + fr;
                float ss = 0.f;
#pragma unroll
                for (int bj = 0; bj < 2; ++bj)
#pragma unroll
                    for (int n = 0; n < 2; ++n) {
                        const int col = u.pn * 256 + bj * 128 + wc * 32 + n * 16 + 4 * fq;
                        const f32x4 h = acc[ai][bj][m][n];
                        *(f32x4*)(H + (size_t)row * DM + col) = h;
                        u32x2 w; w.x = cvt_pk_bf16(h[0], h[1]); w.y = cvt_pk_bf16(h[2], h[3]);
                        *(u32x2*)(HB + (size_t)row * DM + col) = w;
                        ss += h[0] * h[0] + h[1] * h[1] + h[2] * h[2] + h[3] * h[3];
                    }
                ss += __shfl_xor(ss, 16); ss += __shfl_xor(ss, 32);
                if (fq == 0) atomicAdd(rowss + row, ss);
            }
    }
};
struct EpiS {
    static constexpr bool PERM = false, AFTER_DRAIN = false, INIT_ACC = false;
    const float* rowss; float* S; int row0;
    __device__ __forceinline__ void operator()(const f32x4 (&acc)[2][2][4][2], const pg8::Unit& u, int wr, int wc, int fr, int fq) const {
#pragma unroll
        for (int ai = 0; ai < 2; ++ai)
#pragma unroll
            for (int m = 0; m < 4; ++m) {
                const int row = row0 + u.pm * 256 + ai * 128 + wr * 64 + m * 16 + fr;
                const float rs = rsqrtf(rowss[row] * (1.0f / DM) + EPS);
#pragma unroll
                for (int bj = 0; bj < 2; ++bj)
#pragma unroll
                    for (int n = 0; n < 2; ++n) {
                        const int col = u.pn * 256 + bj * 128 + wc * 32 + n * 16 + 4 * fq;
                        *(f32x4*)(S + (size_t)row * NPQ + col) = acc[ai][bj][m][n] * rs;
                    }
            }
    }
};

template <int CTRL> __device__ __forceinline__ float dpp_f(float x) { return __uint_as_float((unsigned)__builtin_amdgcn_update_dpp(0, (int)__float_as_uint(x), CTRL, 0xf, 0xf, false)); }
template <int CTRL> __device__ __forceinline__ int dpp_i(int x) { return __builtin_amdgcn_update_dpp(0, x, CTRL, 0xf, 0xf, false); }
template <int GS> __device__ __forceinline__ int grp_sum_i(int v) { v += dpp_i<0xB1>(v); v += dpp_i<0x4E>(v); if (GS == 8) v += dpp_i<0x141>(v); return v; }
template <int GS> __device__ __forceinline__ float grp_max_f(float v) { v = fmaxf(v, dpp_f<0xB1>(v)); v = fmaxf(v, dpp_f<0x4E>(v)); if (GS == 8) v = fmaxf(v, dpp_f<0x141>(v)); return v; }
template <int GS> __device__ __forceinline__ float grp_min_f(float v) { v = fminf(v, dpp_f<0xB1>(v)); v = fminf(v, dpp_f<0x4E>(v)); if (GS == 8) v = fminf(v, dpp_f<0x141>(v)); return v; }
__device__ __forceinline__ float row_max_f(float v) { v = fmaxf(v, dpp_f<0x128>(v)); v = fmaxf(v, dpp_f<0x124>(v)); v = fmaxf(v, dpp_f<0x122>(v)); v = fmaxf(v, dpp_f<0x121>(v)); return v; }
__device__ __forceinline__ float row_sum_f(float v) { v += dpp_f<0x128>(v); v += dpp_f<0x124>(v); v += dpp_f<0x122>(v); v += dpp_f<0x121>(v); return v; }


struct WT { const bf16_t* q; size_t qstride; const bf16_t* k; const bf16_t* v; size_t kstride; int i0; float slope2; };
typedef short s16x4 __attribute__((ext_vector_type(4)));
__device__ __forceinline__ void attn_tile(const WT& w, float kbound, float mfloor, LAS unsigned char* stg, f32x16 (&O)[2], float& ltot, float& Mq) {
    const int lane = threadIdx.x & 63, tq = lane & 31, g = lane >> 5;
    bf16x8 qb[4];
    float qq = 0.f;
#pragma unroll
    for (int c = 0; c < 4; ++c) {
        const u32x4 raw = *(const u32x4*)(w.q + (size_t)tq * w.qstride + 16 * c + 8 * g);
        qb[c] = __builtin_bit_cast(bf16x8, raw);
        const unsigned ww[4] = {raw.x, raw.y, raw.z, raw.w};
#pragma unroll
        for (int e = 0; e < 4; ++e) { const float lo = bf_lo(ww[e]), hi = bf_hi(ww[e]); qq += lo * lo + hi * hi; }
    }
    qq += __shfl_xor(qq, 32);
    Mq = fmaxf(sqrtf(qq) * kbound, mfloor);
#pragma unroll
    for (int dt = 0; dt < 2; ++dt)
#pragma unroll
        for (int i = 0; i < 16; ++i) O[dt][i] = 0.f;
    float lsum = 0.f;
    const int jbase = w.i0 - 128;
    const int kap = (tq & ~12) | ((tq & 8) >> 1) | ((tq & 4) << 1);
#define ATT_LOAD(KT, KK, VV) do { const int j0_ = jbase + 32 * (KT); const int jk_ = max(j0_ + kap, 0); \
        _Pragma("unroll") for (int c = 0; c < 4; ++c) KK[c] = *(const bf16x8*)(w.k + (size_t)jk_ * w.kstride + 16 * c + 8 * g); \
        _Pragma("unroll") for (int t = 0; t < 2; ++t) { const int jv_ = max(j0_ + 16 * t + (lane >> 2), 0); const bf16_t* vp_ = w.v + (size_t)jv_ * w.kstride + 16 * (lane & 3); VV[t][0] = *(const u32x4*)vp_; VV[t][1] = *(const u32x4*)(vp_ + 8); } } while (0)
    const int kt0 = max(0, (128 - w.i0) >> 5);
    bf16x8 ka[4]; u32x4 vv[2][2];
    ATT_LOAD(kt0, ka, vv);
#pragma unroll 1
    for (int kt = kt0; kt < 5; ++kt) {
        const int j0 = jbase + 32 * kt;
        bf16x8 nk[4]; u32x4 nv[2][2];
        { const int ktn = min(kt + 1, 4); ATT_LOAD(ktn, nk, nv); }
        f32x16 S;
#pragma unroll
        for (int i = 0; i < 16; ++i) S[i] = 0.f;
#pragma unroll
        for (int c = 0; c < 4; ++c) S = __builtin_amdgcn_mfma_f32_32x32x16_bf16(ka[c], qb[c], S, 0, 0, 0);
        const int dbase = tq + 128 - 32 * kt - 8 * g;
        unsigned pw[8];
#pragma unroll
        for (int i2 = 0; i2 < 8; ++i2) {
            float p[2];
#pragma unroll
            for (int e = 0; e < 2; ++e) {
                const int i = 2 * i2 + e, ko = 16 * (i >> 3) + (i & 7);
                const int dist = dbase - ko;
                const bool valid = (j0 + 8 * g + ko >= 0) && (dist >= 0) && (dist <= 128);
                const float s2 = S[i] - w.slope2 * (float)dist - Mq;
                p[e] = valid ? __builtin_amdgcn_exp2f(s2) : 0.f;
                lsum += p[e];
            }
            pw[i2] = cvt_pk_bf16(p[0], p[1]);
        }
        bf16x8 pb[2];
        { u32x4 t0 = {pw[0], pw[1], pw[2], pw[3]}, t1 = {pw[4], pw[5], pw[6], pw[7]}; pb[0] = __builtin_bit_cast(bf16x8, t0); pb[1] = __builtin_bit_cast(bf16x8, t1); }
#pragma unroll
        for (int t = 0; t < 2; ++t) {
            LAS unsigned char* wp = stg + (lane & 2) * 512 + (lane >> 2) * 64 + (lane & 1) * 32;
            *(LAS u32x4*)wp = vv[t][0]; *(LAS u32x4*)(wp + 16) = vv[t][1];
            asm volatile("" ::: "memory");
#pragma unroll
            for (int dt = 0; dt < 2; ++dt) {
                const LAS unsigned char* rp = stg + dt * 1024 + (8 * g + ((lane & 15) >> 2)) * 64 + (16 * ((lane >> 4) & 1) + 4 * (lane & 3)) * 2;
                const s16x4 lo4 = __builtin_amdgcn_ds_read_tr16_b64_v4i16((LAS s16x4*)rp), hi4 = __builtin_amdgcn_ds_read_tr16_b64_v4i16((LAS s16x4*)(rp + 256));
                const bf16x8 va = {lo4[0], lo4[1], lo4[2], lo4[3], hi4[0], hi4[1], hi4[2], hi4[3]};
                O[dt] = __builtin_amdgcn_mfma_f32_32x32x16_bf16(va, pb[t], O[dt], 0, 0, 0);
            }
            asm volatile("" ::: "memory");
        }
#pragma unroll
        for (int c = 0; c < 4; ++c) ka[c] = nk[c];
        vv[0][0] = nv[0][0]; vv[0][1] = nv[0][1]; vv[1][0] = nv[1][0]; vv[1][1] = nv[1][1];
    }
#undef ATT_LOAD
    ltot = lsum + __shfl_xor(lsum, 32);
}

template <int NBR>
__device__ __forceinline__ void sample_task(const f32x4 q4, float M, const float* kc, const float* vc, const float* kn, const float* vn, int Lc, int rstride, int i, float slope2, f32x4& O, float& l) {
    O = (f32x4){0.f, 0.f, 0.f, 0.f}; l = 0.f;
#pragma unroll 1
    for (int br = 0; br < NBR; ++br) {
        const int d = 1 << (2 * br);
#pragma unroll 1
        for (int jb = 0; jb < 136; jb += 8) {
            f32x4 k4[8], v4[8];
#pragma unroll
            for (int e = 0; e < 8; ++e) {
                const int j = min(jb + e, 128), idx = Lc + i - j * d;
                const float* kp = idx < Lc ? kc + (size_t)idx * rstride : kn + (size_t)(idx - Lc) * rstride;
                const float* vp = idx < Lc ? vc + (size_t)idx * rstride : vn + (size_t)(idx - Lc) * rstride;
                k4[e] = *(const f32x4*)kp; v4[e] = *(const f32x4*)vp;
            }
#pragma unroll
            for (int e = 0; e < 8; ++e) {
                float dot = q4[0] * k4[e][0] + q4[1] * k4[e][1] + q4[2] * k4[e][2] + q4[3] * k4[e][3];
                dot += __shfl_xor(dot, 1); dot += __shfl_xor(dot, 2); dot += __shfl_xor(dot, 4); dot += __shfl_xor(dot, 8);
                const int j = jb + e;
                const float s2 = dot - slope2 * (float)(j * d) - M;
                const float p = (j <= 128) ? __builtin_amdgcn_exp2f(s2) : 0.f;
                l += p; O = O + v4[e] * p;
            }
        }
    }
}

__device__ __forceinline__ void bar4(LAS unsigned* cnt, unsigned& epoch) {
    asm volatile("s_waitcnt vmcnt(0) lgkmcnt(0)" ::: "memory");
    epoch += 4u;
    if ((threadIdx.x & 63) == 0) {
        __hip_atomic_fetch_add(cnt, 1u, __ATOMIC_RELAXED, __HIP_MEMORY_SCOPE_WORKGROUP);
        while (__hip_atomic_load(cnt, __ATOMIC_RELAXED, __HIP_MEMORY_SCOPE_WORKGROUP) < epoch) __builtin_amdgcn_s_sleep(1);
    }
    asm volatile("" ::: "memory");
}


__device__ __forceinline__ void late_prologue(const Args& a, LAS unsigned char* lds, LAS unsigned* rbc, unsigned& ep, const int aw) {
    const int t = threadIdx.x - 256, lane = t & 63, G = gridDim.x, bid = blockIdx.x;
    unsigned char* ws = a.ws;
    {
        LAS float* T = (LAS float*)lds;
        bf16_t* BT2 = (bf16_t*)(ws + WS_BT2);
        for (int tl = bid; tl < 256; tl += G) {
            const int ct = tl >> 4, dt = tl & 15;
            const int ty = t >> 6, tx = t & 63;
#pragma unroll
            for (int k = 0; k < 16; ++k) { const int dd = ty + 4 * k; T[dd * 65 + tx] = a.in[13][(size_t)(dt * 64 + dd) * DM + ct * 64 + tx]; }
            bar4(rbc, ep);
            const int cc = t >> 2, dsg = t & 3;
#pragma unroll
            for (int hf = 0; hf < 2; ++hf) {
                const int d8 = 16 * dsg + 8 * hf;
                u32x4 w; w.x = cvt_pk_bf16(T[(d8 + 0) * 65 + cc], T[(d8 + 1) * 65 + cc]); w.y = cvt_pk_bf16(T[(d8 + 2) * 65 + cc], T[(d8 + 3) * 65 + cc]);
                w.z = cvt_pk_bf16(T[(d8 + 4) * 65 + cc], T[(d8 + 5) * 65 + cc]); w.w = cvt_pk_bf16(T[(d8 + 6) * 65 + cc], T[(d8 + 7) * 65 + cc]);
                *(u32x4*)(BT2 + (size_t)(ct * 64 + cc) * DM + dt * 64 + d8) = w;
            }
            bar4(rbc, ep);
        }
    }
    {
        LAS float* Kt = (LAS float*)lds;
        LAS float* Wt = Kt + 128 * 129;
        bf16_t* BT3 = (bf16_t*)(ws + WS_BT3);
        for (int tl = bid; tl < 256; tl += G) {
            const int hp = tl >> 4, d0 = (tl & 15) * 64;
            const float* keys = a.in[16] + (size_t)hp * 16384;
#pragma unroll
            for (int k = 0; k < 16; ++k) { const int e = (t + 256 * k) * 4; const f32x4 v = *(const f32x4*)(keys + e); const int n = e >> 7, c = e & 127;
                Kt[n * 129 + c] = v[0]; Kt[n * 129 + c + 1] = v[1]; Kt[n * 129 + c + 2] = v[2]; Kt[n * 129 + c + 3] = v[3]; }
#pragma unroll
            for (int k = 0; k < 8; ++k) { const int e = (t + 256 * k) * 4; const int dd = e >> 7, c = e & 127;
                *(LAS f32x4*)(Wt + dd * 128 + c) = *(const f32x4*)(a.in[15] + (size_t)(d0 + dd) * NPQ + hp * 128 + c); }
            bar4(rbc, ep);
            const int n = t & 127;
#pragma unroll 1
            for (int rep = 0; rep < 2; ++rep) {
                const int dq = (t >> 7) + 2 * rep;
                float acc[16];
#pragma unroll
                for (int j = 0; j < 16; ++j) acc[j] = 0.f;
                for (int c4 = 0; c4 < 32; ++c4) {
                    const float k0 = Kt[n * 129 + 4 * c4], k1 = Kt[n * 129 + 4 * c4 + 1], k2 = Kt[n * 129 + 4 * c4 + 2], k3 = Kt[n * 129 + 4 * c4 + 3];
#pragma unroll
                    for (int j = 0; j < 16; ++j) { const f32x4 w = *(const LAS f32x4*)(Wt + (dq * 16 + j) * 128 + 4 * c4); acc[j] += k0 * w[0] + k1 * w[1] + k2 * w[2] + k3 * w[3]; }
                }
                const float* gf = a.in[14] + d0 + dq * 16;
                u32x4 w0, w1;
                w0.x = cvt_pk_bf16(acc[0] * gf[0], acc[1] * gf[1]); w0.y = cvt_pk_bf16(acc[2] * gf[2], acc[3] * gf[3]); w0.z = cvt_pk_bf16(acc[4] * gf[4], acc[5] * gf[5]); w0.w = cvt_pk_bf16(acc[6] * gf[6], acc[7] * gf[7]);
                w1.x = cvt_pk_bf16(acc[8] * gf[8], acc[9] * gf[9]); w1.y = cvt_pk_bf16(acc[10] * gf[10], acc[11] * gf[11]); w1.z = cvt_pk_bf16(acc[12] * gf[12], acc[13] * gf[13]); w1.w = cvt_pk_bf16(acc[14] * gf[14], acc[15] * gf[15]);
                bf16_t* dst = BT3 + (size_t)(hp * 128 + n) * DM + d0 + dq * 16;
                *(u32x4*)dst = w0; *(u32x4*)(dst + 8) = w1;
            }
            bar4(rbc, ep);
        }
    }
}

__device__ __forceinline__ void tables_fp8(const Args& a, const int widx, const int nwtot) {
    const int lane = threadIdx.x & 63;
    unsigned char* ws = a.ws;
    {
        f32x4 gn[4];
#pragma unroll
        for (int k = 0; k < 4; ++k) gn[k] = *(const f32x4*)(a.in[14] + k * 256 + lane * 4);
        const int rstep = nwtot * 2;
        int r0 = widx * 2;
        f32x4 v[2][4];
#define TB_LOAD(R0, V) do { _Pragma("unroll") for (int rr2 = 0; rr2 < 2; ++rr2) { const int r = min((R0) + rr2, 2 * NEXP - 1); const bool second = r >= NEXP; const int rr = second ? r - NEXP : r; \
            const float* src = (second ? a.in[18] : a.in[17]) + (size_t)rr * DM; _Pragma("unroll") for (int k = 0; k < 4; ++k) V[rr2][k] = __builtin_nontemporal_load((const f32x4*)(src + k * 256 + lane * 4)); } } while (0)
        if (r0 < 2 * NEXP) TB_LOAD(r0, v);
        for (; r0 < 2 * NEXP; r0 += rstep) {
            f32x4 vn[2][4]; float mx[2];
            TB_LOAD(r0 + rstep, vn);
#pragma unroll
            for (int rr2 = 0; rr2 < 2; ++rr2) {
                const bool second = r0 + rr2 >= NEXP;
                float m = 0.f;
#pragma unroll
                for (int k = 0; k < 4; ++k) { if (!second) v[rr2][k] = v[rr2][k] * gn[k]; m = fmaxf(m, fmaxf(fmaxf(fabsf(v[rr2][k][0]), fabsf(v[rr2][k][1])), fmaxf(fabsf(v[rr2][k][2]), fabsf(v[rr2][k][3])))); }
                m = row_max_f(m); m = fmaxf(m, __shfl_xor(m, 16)); m = fmaxf(m, __shfl_xor(m, 32)); mx[rr2] = m;
            }
#pragma unroll
            for (int rr2 = 0; rr2 < 2; ++rr2) {
                const int r = r0 + rr2; const bool second = r >= NEXP; const int rr = second ? r - NEXP : r;
                const float m = mx[rr2], sc = m > 0.f ? 440.0f / m : 1.0f;
                if (lane == 0) ((float*)(ws + WS_USC))[2 * rr + (second ? 1 : 0)] = m > 0.f ? m * (1.0f / 440.0f) : 1.0f;
                unsigned char* dst = ws + (second ? WS_V8 : WS_U8) + (size_t)rr * 128 + (lane & 31) * 4;
#pragma unroll
                for (int k = 0; k < 4; ++k) { unsigned pk = __builtin_amdgcn_cvt_pk_fp8_f32(v[rr2][k][0] * sc, v[rr2][k][1] * sc, 0, false); pk = __builtin_amdgcn_cvt_pk_fp8_f32(v[rr2][k][2] * sc, v[rr2][k][3] * sc, pk, true);
                    *(unsigned*)(dst + (size_t)(2 * k + (lane >> 5)) * SLICE_BYTES) = pk; }
            }
#pragma unroll
            for (int rr2 = 0; rr2 < 2; ++rr2)
#pragma unroll
                for (int k = 0; k < 4; ++k) v[rr2][k] = vn[rr2][k];
        }
#undef TB_LOAD
    }
}

__device__ __forceinline__ void sample_mixer_b(const Args& a, const int wave0, const int NWR) {
    const int tid = threadIdx.x, lane = tid & 63, aw = __builtin_amdgcn_readfirstlane(tid >> 6) - wave0, G = gridDim.x, bid = blockIdx.x;
    unsigned char* ws = a.ws; float* out = a.out;
    const bf16_t* QB = (const bf16_t*)(ws + WS_QB); bf16_t* CAT = (bf16_t*)(ws + WS_CAT);
    const float kbB = wave_max(fabsf(a.in[11][lane])) * 8.0f * 1.01f;
    {
        for (int task = bid * NWR + aw; task < DB * DS * 2; task += G * NWR) {
            const int b = task >> 4, i = (task >> 1) & 7, kv = task & 1, hq = 4 * kv + (lane >> 4), dl = 4 * (lane & 15);
            const int row = NTP + b * DS + i;
            const u32x2 qr = *(const u32x2*)(QB + (size_t)row * 512 + hq * 64 + dl);
            const f32x4 q4 = {bf_lo(qr.x), bf_hi(qr.x), bf_lo(qr.y), bf_hi(qr.y)};
            const float qq = row_sum_f(q4[0] * q4[0] + q4[1] * q4[1] + q4[2] * q4[2] + q4[3] * q4[3]);
            const float sink2 = a.in[12][hq] * LOG2E;
            const float M = fmaxf(sqrtf(qq) * kbB, sink2);
            const size_t co = ((size_t)b * LBW * 2 + kv) * 64 + dl, no = ((size_t)(b * LBW + LBW - DS) * 2 + kv) * 64 + dl;
            f32x4 O; float l;
            sample_task<1>(q4, M, a.in[4] + co, a.in[5] + co, out + O_BKS + no, out + O_BVS + no, LBW, 128, i, alibi_slope(hq) * LOG2E, O, l);
            l += __builtin_amdgcn_exp2f(sink2 - M);
            const float inv = 1.0f / l;
            u32x2 w; w.x = cvt_pk_bf16(O[0] * inv, O[1] * inv); w.y = cvt_pk_bf16(O[2] * inv, O[3] * inv);
            *(u32x2*)(CAT + (size_t)row * DM + 512 + hq * 64 + dl) = w;
        }
        {
            const size_t gtid = (size_t)bid * (NWR * 64) + (tid - wave0 * 64), gstr = (size_t)G * (NWR * 64);
            const size_t perB = (size_t)(LBW - DS) * 128 / 4, totB = perB * DB;
            for (int t = 0; t < 2; ++t) {
                const f32x4* src = (const f32x4*)a.in[4 + t]; f32x4* dst = (f32x4*)(out + (t ? O_BVS : O_BKS));
                for (size_t i = gtid; i < totB; i += gstr) {
                    const size_t b = i / perB, off = i - b * perB;
                    const f32x4 v = __builtin_nontemporal_load(src + b * (LBW * 128 / 4) + DS * 128 / 4 + off);
                    __builtin_nontemporal_store(v, dst + b * (LBW * 128 / 4) + off);
                }
            }
        }
    }
}

__device__ __forceinline__ void p2_attention(const Args& a, LAS unsigned char* lds) {
    const int tid = threadIdx.x, lane = tid & 63, wave = __builtin_amdgcn_readfirstlane(tid >> 6), G = gridDim.x, bid = blockIdx.x;
    unsigned char* ws = a.ws; float* out = a.out;
    const bf16_t* QA = (const bf16_t*)(ws + WS_QA); const bf16_t* KA = (const bf16_t*)(ws + WS_KA); const bf16_t* VA = (const bf16_t*)(ws + WS_VAT);
    const bf16_t* QB = (const bf16_t*)(ws + WS_QB); const bf16_t* KB = (const bf16_t*)(ws + WS_KB); const bf16_t* VBN = (const bf16_t*)(ws + WS_VBT);
    bf16_t* CAT = (bf16_t*)(ws + WS_CAT);
    LAS unsigned* rb = (LAS unsigned*)(lds + LDS_BARW - 16);
    if (tid < 2) rb[tid] = 0u;
    __syncthreads();
    {
        constexpr int NWR = 8;
        const int aw = wave;
        const float kbA = wave_max(fabsf(a.in[9][lane])) * 8.0f * 1.01f, kbB = wave_max(fabsf(a.in[11][lane])) * 8.0f * 1.01f;
        const int tq = lane & 31, g = lane >> 5;
        LAS unsigned char* stg = lds + 141312 + aw * 2048;
        unsigned ep = 0u;
        for (int wt = bid * NWR + aw; wt < NB * 8 * (SEQ / 32); wt += G * NWR) {
            const int b = wt >> 10, hq = (wt >> 7) & 7, T = wt & 127, kv = hq >> 2, i0 = 32 * T;
            WT w; w.q = QB + ((size_t)(b * SEQ + i0)) * 512 + hq * 64; w.qstride = 512;
            w.k = KB + ((size_t)b * SEQ) * 128 + kv * 64; w.v = VBN + ((size_t)b * SEQ) * 128 + kv * 64; w.kstride = 128;
            w.i0 = i0; w.slope2 = alibi_slope(hq) * LOG2E;
            const float sink2 = a.in[12][hq] * LOG2E;
            f32x16 O[2]; float l, Mq;
            attn_tile(w, kbB, sink2, stg, O, l, Mq);
            l += __builtin_amdgcn_exp2f(sink2 - Mq);
            const float inv = 1.0f / l;
            bf16_t* dst = CAT + (size_t)(b * SEQ + i0 + tq) * DM + 512 + hq * 64;
#pragma unroll
            for (int dt = 0; dt < 2; ++dt)
#pragma unroll
                for (int i4 = 0; i4 < 4; ++i4) {
                    u32x2 pkw; pkw.x = cvt_pk_bf16(O[dt][4 * i4] * inv, O[dt][4 * i4 + 1] * inv); pkw.y = cvt_pk_bf16(O[dt][4 * i4 + 2] * inv, O[dt][4 * i4 + 3] * inv);
                    *(u32x2*)(dst + 32 * dt + 8 * i4 + 4 * g) = pkw;
                }
        }
        {
            LAS float* ACC = (LAS float*)lds;
            LAS float* LS = ACC + 512 * 68;
            for (int unit = bid; unit < NB * 8 * (SEQ / 512); unit += G) {
                const int b = unit >> 6, h = (unit >> 3) & 7, q0 = (unit & 7) * 512;
#pragma unroll 1
                for (int pass = 0; pass < 3; ++pass) {
                    const int sh = 2 * pass, d = 1 << sh;
#pragma unroll 1
                    for (int tt = 0; tt < 16 / NWR; ++tt) {
                        const int T = aw + NWR * tt;
                        int res, i0, qlb, qls;
                        if (pass == 0) { res = 0; i0 = q0 + 32 * T; qlb = 32 * T; qls = 1; }
                        else if (pass == 1) { res = T >> 2; i0 = (q0 >> 2) + 32 * (T & 3); qlb = 128 * (T & 3) + res; qls = 4; }
                        else { res = T; i0 = q0 >> 4; qlb = res; qls = 16; }
                        WT w; w.q = QA + ((size_t)(b * SEQ + res) + (size_t)i0 * d) * 512 + h * 64; w.qstride = (size_t)d * 512;
                        w.k = KA + ((size_t)(b * SEQ + res)) * 512 + h * 64; w.v = VA + ((size_t)(b * SEQ + res)) * 512 + h * 64; w.kstride = (size_t)d * 512;
                        w.i0 = i0; w.slope2 = alibi_slope(h) * (float)d * LOG2E;
                        f32x16 O[2]; float l, Mq;
                        attn_tile(w, kbA, -3.0e38f, stg, O, l, Mq);
                        const int ql = qlb + tq * qls;
                        LAS float* ar = ACC + ql * 68 + 4 * g;
                        if (pass == 0) {
#pragma unroll
                            for (int dt = 0; dt < 2; ++dt)
#pragma unroll
                                for (int i4 = 0; i4 < 4; ++i4) *(LAS f32x4*)(ar + 32 * dt + 8 * i4) = (f32x4){O[dt][4 * i4], O[dt][4 * i4 + 1], O[dt][4 * i4 + 2], O[dt][4 * i4 + 3]};
                            if (g == 0) LS[ql] = l;
                        } else if (pass == 1) {
#pragma unroll
                            for (int dt = 0; dt < 2; ++dt)
#pragma unroll
                                for (int i4 = 0; i4 < 4; ++i4) { const f32x4 o = *(LAS f32x4*)(ar + 32 * dt + 8 * i4); *(LAS f32x4*)(ar + 32 * dt + 8 * i4) = o + (f32x4){O[dt][4 * i4], O[dt][4 * i4 + 1], O[dt][4 * i4 + 2], O[dt][4 * i4 + 3]}; }
                            if (g == 0) LS[ql] += l;
                        } else {
                            const float inv = 1.0f / (LS[ql] + l);
                            bf16_t* dst = CAT + (size_t)(b * SEQ + q0 + ql) * DM + h * 64 + 4 * g;
#pragma unroll
                            for (int dt = 0; dt < 2; ++dt)
#pragma unroll
                                for (int i4 = 0; i4 < 4; ++i4) {
                                    const f32x4 o = *(LAS f32x4*)(ar + 32 * dt + 8 * i4);
                                    u32x2 pkw; pkw.x = cvt_pk_bf16((o[0] + O[dt][4 * i4]) * inv, (o[1] + O[dt][4 * i4 + 1]) * inv); pkw.y = cvt_pk_bf16((o[2] + O[dt][4 * i4 + 2]) * inv, (o[3] + O[dt][4 * i4 + 3]) * inv);
                                    *(u32x2*)(dst + 32 * dt + 8 * i4) = pkw;
                                }
                        }
                    }
                    if (NWR == 8) __syncthreads(); else bar4(rb + 1, ep);
                }
            }
        }
        if (CONV_IN_P1 && G == 256) { }
        else if (wave >= 4) late_prologue(a, lds, rb + 1, ep, wave - 4); else tables_fp8(a, bid * 4 + wave, G * 4);
    }
    __syncthreads();
}

__device__ __forceinline__ float gelu_erf(float x) { return 0.5f * x * (1.0f + erff(x * 0.70710678118654752f)); }

template <int GS> __device__ __forceinline__ void bisect16(const float (&x)[32], float& lo, float& hi) {
    float mx = x[0], mn = x[0];
#pragma unroll
    for (int j = 1; j < 32; ++j) { mx = fmaxf(mx, x[j]); mn = fminf(mn, x[j]); }
    hi = grp_max_f<GS>(mx); lo = grp_min_f<GS>(mn);
    bool done = false;
#pragma unroll 1
    for (int it = 0; it < 48; ++it) {
        const float t = 0.5f * (lo + hi);
        const bool conv = !(t > lo && t < hi);
        int cnt = 0;
#pragma unroll
        for (int j = 0; j < 32; ++j) cnt += (x[j] >= t) ? 1 : 0;
        cnt = grp_sum_i<GS>(cnt);
        const bool upd = !done && !conv, ex = cnt == 16, gt = cnt > 16;
        const float nlo = (ex || gt) ? t : lo, nhi = (ex || !gt) ? t : hi;
        lo = upd ? nlo : lo; hi = upd ? nhi : hi;
        done = done || conv || ex;
        if (__ballot(!done) == 0ull) break;
    }
}

__device__ __forceinline__ void peer_select(const float* S, const int row, const int lane, LAS float* sv, LAS int* si, LAS float* fvL, LAS int* eL, int& e0o, int& e1o, float& g0o, float& g1o) {
        {
            const int grp = lane >> 2, qtr = lane & 3;
            float x[32];
            const float* sp = S + (size_t)row * NPQ + grp * 128 + qtr * 32;
#pragma unroll
            for (int k = 0; k < 8; ++k) { const f32x4 v = *(const f32x4*)(sp + 4 * k); x[4 * k] = v[0]; x[4 * k + 1] = v[1]; x[4 * k + 2] = v[2]; x[4 * k + 3] = v[3]; }
            float lo, hi;
            bisect16<4>(x, lo, hi);
            int cA = 0, cB = 0;
#pragma unroll
            for (int j = 0; j < 32; ++j) { cA += (x[j] >= hi) ? 1 : 0; cB += (x[j] >= lo && x[j] < hi) ? 1 : 0; }
            const int pk = cA | (cB << 8);
            const int q0 = dpp_i<0x00>(pk), q1 = dpp_i<0x55>(pk), q2 = dpp_i<0xAA>(pk), q3 = dpp_i<0xFF>(pk);
            const int tot = q0 + q1 + q2 + q3, pre = (qtr > 0 ? q0 : 0) + (qtr > 1 ? q1 : 0) + (qtr > 2 ? q2 : 0);
            int pA = pre & 255, pB = (tot & 255) + (pre >> 8);
            asm volatile("" : "+v"(lo), "+v"(hi));
#pragma unroll
            for (int j = 0; j < 32; ++j) {
                const bool isA = x[j] >= hi, isB = !isA && x[j] >= lo;
                const int slot = isA ? pA : pB;
                if ((isA || isB) && slot < 16) { sv[grp * 16 + slot] = x[j]; si[grp * 16 + slot] = qtr * 32 + j; }
                pA += isA ? 1 : 0; pB += isB ? 1 : 0;
            }
        }
        __builtin_amdgcn_wave_barrier();
        {
            const int hd = lane >> 3, sub = lane & 7;
            const float s1a = sv[(2 * hd) * 16 + 2 * sub], s1b = sv[(2 * hd) * 16 + 2 * sub + 1];
            const int i1a = si[(2 * hd) * 16 + 2 * sub], i1b = si[(2 * hd) * 16 + 2 * sub + 1];
            float c[32]; int i2[16];
#pragma unroll
            for (int k = 0; k < 4; ++k) {
                const f32x4 v = *(const LAS f32x4*)(sv + (2 * hd + 1) * 16 + 4 * k);
                const u32x4 iv = *(const LAS u32x4*)(si + (2 * hd + 1) * 16 + 4 * k);
#pragma unroll
                for (int e = 0; e < 4; ++e) { c[4 * k + e] = s1a + v[e]; c[16 + 4 * k + e] = s1b + v[e]; }
                i2[4 * k] = (int)iv.x; i2[4 * k + 1] = (int)iv.y; i2[4 * k + 2] = (int)iv.z; i2[4 * k + 3] = (int)iv.w;
            }
            float lo, hi;
            bisect16<8>(c, lo, hi);
            int cA = 0, cB = 0;
#pragma unroll
            for (int j = 0; j < 32; ++j) { cA += (c[j] >= hi) ? 1 : 0; cB += (c[j] >= lo && c[j] < hi) ? 1 : 0; }
            const int pk = cA | (cB << 8);
            int inc = pk;
            { int t = __shfl_up(inc, 1, 8); if (sub >= 1) inc += t; t = __shfl_up(inc, 2, 8); if (sub >= 2) inc += t; t = __shfl_up(inc, 4, 8); if (sub >= 4) inc += t; }
            const int tot = __shfl(inc, 7, 8), pre = inc - pk;
            int pA = pre & 255, pB = (tot & 255) + (pre >> 8);
            asm volatile("" : "+v"(lo), "+v"(hi));
#pragma unroll
            for (int j = 0; j < 32; ++j) {
                const bool isA = c[j] >= hi, isB = !isA && c[j] >= lo;
                const int slot = isA ? pA : pB;
                if ((isA || isB) && slot < 16) { fvL[hd * 16 + slot] = c[j]; eL[hd * 16 + slot] = (j < 16 ? i1a : i1b) * 128 + i2[j & 15]; }
                pA += isA ? 1 : 0; pB += isB ? 1 : 0;
            }
        }
        __builtin_amdgcn_wave_barrier();
        const int e0 = eL[lane], e1 = eL[64 + lane];
        float g0, g1;
        { const float f0 = fvL[lane], f1 = fvL[64 + lane];
          const float p0 = __expf(f0 - row_max_f(f0)), p1 = __expf(f1 - row_max_f(f1));
          g0 = p0 / row_sum_f(p0); g1 = p1 / row_sum_f(p1); }
        e0o = e0; e1o = e1; g0o = g0; g1o = g1;
}

typedef float f32x2 __attribute__((ext_vector_type(2)));
__device__ __forceinline__ f32x2 fp8x2_lo(unsigned w) { return __builtin_amdgcn_cvt_pk_f32_fp8(w, false); }
__device__ __forceinline__ f32x2 fp8x2_hi(unsigned w) { return __builtin_amdgcn_cvt_pk_f32_fp8(w, true); }
template <int CTRL, int BANK> __device__ __forceinline__ float dpp_bank_f(float old, float x) { return __uint_as_float((unsigned)__builtin_amdgcn_update_dpp((int)__float_as_uint(old), (int)__float_as_uint(x), CTRL, 0xf, BANK, false)); }
__device__ __forceinline__ float xor4_f(float x) { float r = dpp_bank_f<0x104, 0x5>(0.f, x); return dpp_bank_f<0x114, 0xa>(r, x); }

__device__ __forceinline__ void peer_topk_w(const Args& a, LAS unsigned char* lds, const int widx, const int nwtot, const int row_lo, const int row_hi);
__device__ __forceinline__ void peer_topk(const Args& a, LAS unsigned char* lds, const int wave0, const int nw, const int row_lo, const int row_hi) {
    const int wave = __builtin_amdgcn_readfirstlane(threadIdx.x >> 6) - wave0;
    peer_topk_w(a, lds, (int)blockIdx.x * nw + wave, (int)gridDim.x * nw, row_lo, row_hi);
}
__device__ __forceinline__ void peer_topk_w(const Args& a, LAS unsigned char* lds, const int widx, const int nwtot, const int row_lo, const int row_hi) {
    const int tid = threadIdx.x, lane = tid & 63;
    unsigned char* ws = a.ws;
    const float* S = (const float*)(ws + WS_S);
    LAS float* sv = (LAS float*)(lds + __builtin_amdgcn_readfirstlane(tid >> 6) * 3072); LAS int* si = (LAS int*)(sv + 256); LAS float* fvL = (LAS float*)(si + 256); LAS int* eL = (LAS int*)(fvL + 128);
    for (int row = row_lo + widx; row < row_hi; row += nwtot) {
        int e0, e1; float g0, g1;
        peer_select(S, row, lane, sv, si, fvL, eL, e0, e1, g0, g1);
        unsigned* kp = (unsigned*)(ws + WS_PEERK) + (size_t)row * 256;
        kp[lane] = (unsigned)e0; kp[64 + lane] = (unsigned)e1; kp[128 + lane] = __float_as_uint(g0); kp[192 + lane] = __float_as_uint(g1);
        __builtin_amdgcn_wave_barrier();
    }
}

struct PeerWork { int j, q0, qstep, nq, W, OFF, row_lo; };
__device__ __forceinline__ int peer_tok(const PeerWork& w, const int q) { return w.row_lo + (q / w.W) * 16 + w.OFF + (q % w.W); }
__device__ __forceinline__ PeerWork peer_work_plain(const int wave, const int nw, const int NI, const int row_lo, const int row_hi) {
    const int bid = blockIdx.x; PeerWork w; w.j = bid & 7; w.q0 = (bid >> 3) + NI * wave; w.qstep = NI * nw; w.nq = row_hi - row_lo; w.W = 16; w.OFF = 0; w.row_lo = row_lo; return w;
}

template <bool NT>
__device__ __forceinline__ void peer_passA(const Args& a, const PeerWork w) {
    const int lane = threadIdx.x & 63;
    const int j = w.j, r = lane >> 3, sub = lane & 7;
    unsigned char* ws = a.ws;
    const unsigned char* Us = ws + WS_U8 + (size_t)j * SLICE_BYTES; const unsigned sub16 = 16u * (unsigned)sub;
    const unsigned* KP = (const unsigned*)(ws + WS_PEERK) + 16 * r;
    const float* H = (const float*)(ws + WS_H) + 128 * j + 16 * sub;
    unsigned* PD = (unsigned*)(ws + WS_PD) + 64 * j + lane;
    const int qs = w.qstep, ql = w.nq - 1;
    int q = w.q0;
    if (q > ql) return;
    u32x4 idv[4], ur[16]; f32x4 hv[4];
#define PA_LD(P) (NT ? __builtin_nontemporal_load((const u32x4*)(P)) : *(const u32x4*)(P))
#define PA_IDS(T) do { const unsigned* kp_ = KP + (size_t)(T) * 256; _Pragma("unroll") for (int qq = 0; qq < 4; ++qq) idv[qq] = *(const u32x4*)(kp_ + 4 * qq); } while (0)
#define PA_GATHER(T, UR, HV) do { _Pragma("unroll") for (int qq = 0; qq < 4; ++qq) { UR[4 * qq] = PA_LD(Us + (idv[qq].x * 128u + sub16)); UR[4 * qq + 1] = PA_LD(Us + (idv[qq].y * 128u + sub16)); \
            UR[4 * qq + 2] = PA_LD(Us + (idv[qq].z * 128u + sub16)); UR[4 * qq + 3] = PA_LD(Us + (idv[qq].w * 128u + sub16)); } \
        const float* hp_ = H + (size_t)(T) * DM; _Pragma("unroll") for (int qq = 0; qq < 4; ++qq) HV[qq] = *(const f32x4*)(hp_ + 4 * qq); } while (0)
    int t = peer_tok(w, q), t1 = peer_tok(w, min(q + qs, ql));
    PA_IDS(t);
    PA_GATHER(t, ur, hv);
    PA_IDS(t1);
#pragma unroll 1
    for (;; q += qs) {
        u32x4 urn[16]; f32x4 hn[4];
        PA_GATHER(t1, urn, hn);
        const int t2 = peer_tok(w, min(q + 2 * qs, ql));
        PA_IDS(t2);
        float part[16];
#pragma unroll
        for (int k = 0; k < 16; ++k) {
            const unsigned ww[4] = {ur[k].x, ur[k].y, ur[k].z, ur[k].w};
            f32x2 p2 = {0.f, 0.f};
#pragma unroll
            for (int wd = 0; wd < 4; ++wd) { p2 = __builtin_elementwise_fma(fp8x2_lo(ww[wd]), (f32x2){hv[wd][0], hv[wd][1]}, p2); p2 = __builtin_elementwise_fma(fp8x2_hi(ww[wd]), (f32x2){hv[wd][2], hv[wd][3]}, p2); }
            part[k] = p2[0] + p2[1];
        }
        float w8[8], w4[4], w2[2];
        { const bool up = (lane & 4) != 0;
#pragma unroll
          for (int m = 0; m < 8; ++m) { const float keep = up ? part[m + 8] : part[m], send = up ? part[m] : part[m + 8]; w8[m] = keep + xor4_f(send); } }
        { const bool up = (lane & 2) != 0;
#pragma unroll
          for (int m = 0; m < 4; ++m) { const float keep = up ? w8[m + 4] : w8[m], send = up ? w8[m] : w8[m + 4]; w4[m] = keep + dpp_f<0x4E>(send); } }
        { const bool up = (lane & 1) != 0;
#pragma unroll
          for (int m = 0; m < 2; ++m) { const float keep = up ? w4[m + 2] : w4[m], send = up ? w4[m] : w4[m + 2]; w2[m] = keep + dpp_f<0xB1>(send); } }
        PD[(size_t)t * 512] = cvt_pk_bf16(w2[0], w2[1]);
        if (q + qs > ql) break;
#pragma unroll
        for (int k = 0; k < 16; ++k) ur[k] = urn[k];
#pragma unroll
        for (int qq = 0; qq < 4; ++qq) hv[qq] = hn[qq];
        t = t1; t1 = t2;
    }
#undef PA_LD
#undef PA_IDS
#undef PA_GATHER
}

__device__ __forceinline__ void peer_coef(const Args& a, const int widx, const int nwtot, const int row_lo, const int row_hi) {
    const int lane = threadIdx.x & 63, half = lane >> 5, l5 = lane & 31;
    unsigned char* ws = a.ws;
    const f32x2* SC = (const f32x2*)(ws + WS_USC); const float* rowss = (const float*)(ws + WS_ROWSS);
    for (int row = row_lo + widx; row < row_hi; row += nwtot) {
        const unsigned* kp = (const unsigned*)(ws + WS_PEERK) + (size_t)row * 256 + 4 * l5;
        const unsigned* pd = (const unsigned*)(ws + WS_PD) + (size_t)row * 512 + half * 256 + 2 * l5;
        const u32x4 ids = *(const u32x4*)kp;
        const f32x4 g = *(const f32x4*)(kp + 128);
        f32x4 d = {0.f, 0.f, 0.f, 0.f};
#pragma unroll
        for (int sl = 0; sl < 4; ++sl) { const u32x2 pw = *(const u32x2*)(pd + sl * 64); d = d + (f32x4){bf_lo(pw.x), bf_hi(pw.x), bf_lo(pw.y), bf_hi(pw.y)}; }
        const f32x2 s0 = SC[ids.x], s1 = SC[ids.y], s2 = SC[ids.z], s3 = SC[ids.w];
        const float rs2 = rsqrtf(rowss[row] * (1.0f / DM) + EPS);
#pragma unroll
        for (int c = 0; c < 4; ++c) d[c] += __shfl_xor(d[c], 32);
        f32x4 cf;
        cf[0] = g[0] * gelu_erf(d[0] * rs2 * s0[0]) * s0[1]; cf[1] = g[1] * gelu_erf(d[1] * rs2 * s1[0]) * s1[1];
        cf[2] = g[2] * gelu_erf(d[2] * rs2 * s2[0]) * s2[1]; cf[3] = g[3] * gelu_erf(d[3] * rs2 * s3[0]) * s3[1];
        if (half == 0) *(f32x4*)((float*)(ws + WS_COEF) + (size_t)row * 128 + 4 * l5) = cf;
    }
}

template <bool NT>
__device__ __forceinline__ void peer_passB(const Args& a, const PeerWork w) {
    const int lane = threadIdx.x & 63;
    const int j = w.j, r = lane >> 3, sub = lane & 7;
    unsigned char* ws = a.ws;
    const unsigned char* Vs = ws + WS_V8 + (size_t)j * SLICE_BYTES; const unsigned sub16 = 16u * (unsigned)sub;
    const unsigned* KP = (const unsigned*)(ws + WS_PEERK) + 16 * r;
    const float* CO = (const float*)(ws + WS_COEF) + 16 * r;
    const float* H = (const float*)(ws + WS_H) + 128 * j + 16 * sub + 2 * r;
    float* Y = a.out + 128 * j + 16 * sub + 2 * r;
    const int qs = w.qstep, ql = w.nq - 1;
    int q = w.q0;
    if (q > ql) return;
    u32x4 idv[4], vr[16]; f32x4 cf[4]; f32x2 hv;
#define PB_LD(P) (NT ? __builtin_nontemporal_load((const u32x4*)(P)) : *(const u32x4*)(P))
#define PB_IDS(T) do { const unsigned* kp_ = KP + (size_t)(T) * 256; _Pragma("unroll") for (int qq = 0; qq < 4; ++qq) idv[qq] = *(const u32x4*)(kp_ + 4 * qq); } while (0)
#define PB_GATHER(T, VR, CF, HV) do { _Pragma("unroll") for (int qq = 0; qq < 4; ++qq) { VR[4 * qq] = PB_LD(Vs + (idv[qq].x * 128u + sub16)); VR[4 * qq + 1] = PB_LD(Vs + (idv[qq].y * 128u + sub16)); \
            VR[4 * qq + 2] = PB_LD(Vs + (idv[qq].z * 128u + sub16)); VR[4 * qq + 3] = PB_LD(Vs + (idv[qq].w * 128u + sub16)); } \
        const float* cp_ = CO + (size_t)(T) * 128; _Pragma("unroll") for (int qq = 0; qq < 4; ++qq) CF[qq] = *(const f32x4*)(cp_ + 4 * qq); \
        HV = *(const f32x2*)(H + (size_t)(T) * DM); } while (0)
    int t = peer_tok(w, q), t1 = peer_tok(w, min(q + qs, ql));
    PB_IDS(t);
    PB_GATHER(t, vr, cf, hv);
    PB_IDS(t1);
#pragma unroll 1
    for (;; q += qs) {
        u32x4 vrn[16]; f32x4 cfn[4]; f32x2 hn;
        PB_GATHER(t1, vrn, cfn, hn);
        const int t2 = peer_tok(w, min(q + 2 * qs, ql));
        PB_IDS(t2);
        f32x2 acc[8];
#pragma unroll
        for (int m = 0; m < 8; ++m) acc[m] = (f32x2){0.f, 0.f};
#pragma unroll
        for (int k = 0; k < 16; ++k) {
            const unsigned ww[4] = {vr[k].x, vr[k].y, vr[k].z, vr[k].w};
            const float c = cf[k >> 2][k & 3]; const f32x2 c2 = {c, c};
#pragma unroll
            for (int wd = 0; wd < 4; ++wd) { acc[2 * wd] = __builtin_elementwise_fma(fp8x2_lo(ww[wd]), c2, acc[2 * wd]); acc[2 * wd + 1] = __builtin_elementwise_fma(fp8x2_hi(ww[wd]), c2, acc[2 * wd + 1]); }
        }
        float w8[8], w4[4], w2[2];
#pragma unroll
        for (int m = 0; m < 8; ++m) { const auto sw = __builtin_amdgcn_permlane32_swap(__float_as_uint(acc[m >> 1][m & 1]), __float_as_uint(acc[(m + 8) >> 1][m & 1]), false, false); w8[m] = __uint_as_float(sw[0]) + __uint_as_float(sw[1]); }
#pragma unroll
        for (int m = 0; m < 4; ++m) { const auto sw = __builtin_amdgcn_permlane16_swap(__float_as_uint(w8[m]), __float_as_uint(w8[m + 4]), false, false); w4[m] = __uint_as_float(sw[0]) + __uint_as_float(sw[1]); }
        { const bool up = (lane & 8) != 0;
#pragma unroll
          for (int m = 0; m < 2; ++m) { const float keep = up ? w4[m + 2] : w4[m], send = up ? w4[m] : w4[m + 2]; w2[m] = keep + dpp_f<0x128>(send); } }
        *(f32x2*)(Y + (size_t)t * DM) = (f32x2){hv[0] + w2[0], hv[1] + w2[1]};
        if (q + qs > ql) break;
#pragma unroll
        for (int k = 0; k < 16; ++k) vr[k] = vrn[k];
#pragma unroll
        for (int qq = 0; qq < 4; ++qq) cf[qq] = cfn[qq];
        hv = hn;
        t = t1; t1 = t2;
    }
#undef PB_LD
#undef PB_IDS
#undef PB_GATHER
}

__device__ __forceinline__ void stream_task(const Args& a, const int task, const int wave, const float kbA, LAS unsigned* rb, unsigned& ep) {
    const int lane = threadIdx.x & 63;
    unsigned char* ws = a.ws; float* out = a.out;
    const bf16_t* QA = (const bf16_t*)(ws + WS_QA); bf16_t* CAT = (bf16_t*)(ws + WS_CAT);
    {
            const int b = task >> 1, hh = task & 1, hd = 4 * hh + (lane >> 4), dl = 4 * (lane & 15);
            const float slope2 = alibi_slope(hd) * LOG2E;
            f32x4 q[8], O[8]; float M[8], l[8];
#pragma unroll
            for (int i = 0; i < 8; ++i) {
                const u32x2 qr = *(const u32x2*)(QA + (size_t)(NTP + b * DS + i) * 512 + hd * 64 + dl);
                q[i] = (f32x4){bf_lo(qr.x), bf_hi(qr.x), bf_lo(qr.y), bf_hi(qr.y)};
                M[i] = sqrtf(row_sum_f(q[i][0] * q[i][0] + q[i][1] * q[i][1] + q[i][2] * q[i][2] + q[i][3] * q[i][3])) * kbA;
                O[i] = (f32x4){0.f, 0.f, 0.f, 0.f}; l[i] = 0.f;
            }
            const f32x4 qa = wave == 0 ? q[0] : wave == 1 ? q[1] : wave == 2 ? q[2] : q[3], qb = wave == 0 ? q[4] : wave == 1 ? q[5] : wave == 2 ? q[6] : q[7];
            const float Ma = wave == 0 ? M[0] : wave == 1 ? M[1] : wave == 2 ? M[2] : M[3], Mb = wave == 0 ? M[4] : wave == 1 ? M[5] : wave == 2 ? M[6] : M[7];
            f32x4 Oa = {0.f, 0.f, 0.f, 0.f}, Ob = {0.f, 0.f, 0.f, 0.f}; float la = 0.f, lb = 0.f;
            const size_t co = ((size_t)b * LA * 8 + hd) * 64 + dl;
            const float* kc = a.in[2] + co; const float* vc = a.in[3] + co; float* ko = out + O_AKS + co; float* vo = out + O_AVS + co;
            constexpr int NGRP = 480 / SB;
            int gq = 0;
            f32x4 k4[SB], v4[SB];
#pragma unroll
            for (int u = 0; u < SB; ++u) { const size_t ro = (size_t)(wave + 4 * (SB * gq + u)) * 512; k4[u] = __builtin_nontemporal_load((const f32x4*)(kc + ro)); v4[u] = __builtin_nontemporal_load((const f32x4*)(vc + ro)); }
#pragma unroll 1
            for (int it = 0; it < NGRP; ++it) {
                const int n0 = SB * gq;
                gq = gq + 1 == NGRP ? 0 : gq + 1;
                f32x4 kn4[SB], vn4[SB];
#pragma unroll
                for (int u = 0; u < SB; ++u) { const size_t ro = (size_t)(wave + 4 * (SB * gq + u)) * 512; kn4[u] = __builtin_nontemporal_load((const f32x4*)(kc + ro)); vn4[u] = __builtin_nontemporal_load((const f32x4*)(vc + ro)); }
#pragma unroll
                for (int u = 0; u < SB; ++u) {
                    const int n = n0 + u;
                    if (n >= 2) { const size_t wo = (size_t)(wave + 4 * n - DS) * 512; __builtin_nontemporal_store(k4[u], (f32x4*)(ko + wo)); __builtin_nontemporal_store(v4[u], (f32x4*)(vo + wo)); }
                    const int da = LA - 4 * n, db = da + 4;
                    const int ma = (da <= 512 ? 1 : 0) + ((da & 15) == 0 ? 1 : 0), mb = (db <= 512 ? 1 : 0) + ((db & 15) == 0 ? 1 : 0);
                    if (ma) {
                        const float dot = row_sum_f(qa[0] * k4[u][0] + qa[1] * k4[u][1] + qa[2] * k4[u][2] + qa[3] * k4[u][3]);
                        const float pp = __builtin_amdgcn_exp2f(dot - slope2 * (float)da - Ma) * (float)ma;
                        la += pp; Oa = Oa + v4[u] * pp;
                    }
                    if (mb) {
                        const float dot = row_sum_f(qb[0] * k4[u][0] + qb[1] * k4[u][1] + qb[2] * k4[u][2] + qb[3] * k4[u][3]);
                        const float pp = __builtin_amdgcn_exp2f(dot - slope2 * (float)db - Mb) * (float)mb;
                        lb += pp; Ob = Ob + v4[u] * pp;
                    }
                }
#pragma unroll
                for (int u = 0; u < SB; ++u) { k4[u] = kn4[u]; v4[u] = vn4[u]; }
            }
#pragma unroll 1
            for (int n0 = 480; n0 < 512; n0 += 4) {
                f32x4 k4[4], v4[4];
#pragma unroll
                for (int u = 0; u < 4; ++u) { const size_t ro = (size_t)(wave + 4 * (n0 + u)) * 512; k4[u] = __builtin_nontemporal_load((const f32x4*)(kc + ro)); v4[u] = __builtin_nontemporal_load((const f32x4*)(vc + ro)); }
#pragma unroll
                for (int u = 0; u < 4; ++u) {
                    const int r = wave + 4 * (n0 + u);
                    { const size_t wo = (size_t)(r - DS) * 512; __builtin_nontemporal_store(k4[u], (f32x4*)(ko + wo)); __builtin_nontemporal_store(v4[u], (f32x4*)(vo + wo)); }
#pragma unroll
                    for (int i = 0; i < 8; ++i) {
                        const int dist = LA + i - r;
                        const int mult = (dist <= 128 ? 1 : 0) + ((dist & 3) == 0 ? 1 : 0) + ((dist & 15) == 0 ? 1 : 0);
                        if (mult) {
                            const float dot = row_sum_f(q[i][0] * k4[u][0] + q[i][1] * k4[u][1] + q[i][2] * k4[u][2] + q[i][3] * k4[u][3]);
                            const float pp = __builtin_amdgcn_exp2f(dot - slope2 * (float)dist - M[i]) * (float)mult;
                            l[i] += pp; O[i] = O[i] + v4[u] * pp;
                        }
                    }
                }
            }
#pragma unroll
            for (int nn = 0; nn < 2; ++nn) {
                const int nr = wave + 4 * nn;
                const size_t no = (size_t)(LA - DS + nr) * 512;
                const f32x4 kn = *(const f32x4*)(ko + no), vn = *(const f32x4*)(vo + no);
#pragma unroll
                for (int i = 0; i < 8; ++i) {
                    const int dist = i - nr;
                    if (dist >= 0) {
                        const int mult = 1 + ((dist & 3) == 0 ? 1 : 0) + (dist == 0 ? 1 : 0);
                        const float dot = row_sum_f(q[i][0] * kn[0] + q[i][1] * kn[1] + q[i][2] * kn[2] + q[i][3] * kn[3]);
                        const float pp = __builtin_amdgcn_exp2f(dot - slope2 * (float)dist - M[i]) * (float)mult;
                        l[i] += pp; O[i] = O[i] + vn * pp;
                    }
                }
            }
#pragma unroll
            for (int i = 0; i < 4; ++i) if (i == wave) { O[i] = O[i] + Oa; l[i] += la; O[i + 4] = O[i + 4] + Ob; l[i + 4] += lb; }
            f32x4* PO = (f32x4*)(ws + WS_SPART + (size_t)task * 40960);
            float* PL = (float*)(ws + WS_SPART + (size_t)task * 40960 + 32768);
#pragma unroll
            for (int i = 0; i < 8; ++i) { PO[(wave * 8 + i) * 64 + lane] = O[i]; PL[(wave * 8 + i) * 64 + lane] = l[i]; }
            bar4(rb, ep);
#pragma unroll
            for (int nn = 0; nn < 2; ++nn) {
                const int i = wave + 4 * nn;
                f32x4 Os = {0.f, 0.f, 0.f, 0.f}; float ls = 0.f;
#pragma unroll
                for (int w2 = 0; w2 < 4; ++w2) { Os = Os + __builtin_nontemporal_load(PO + (w2 * 8 + i) * 64 + lane); ls += __builtin_nontemporal_load(PL + (w2 * 8 + i) * 64 + lane); }
                const float inv = 1.0f / ls;
                u32x2 wv; wv.x = cvt_pk_bf16(Os[0] * inv, Os[1] * inv); wv.y = cvt_pk_bf16(Os[2] * inv, Os[3] * inv);
                *(u32x2*)(CAT + (size_t)(NTP + b * DS + i) * DM + hd * 64 + dl) = wv;
            }
    }
}

#define XB_PB(k) (32 * (k))
__device__ __forceinline__ void peer_barrier(unsigned* bar, const int k, const unsigned expected) {
    asm volatile("s_waitcnt vmcnt(0)" ::: "memory");
    __syncthreads();
    if (threadIdx.x == 0) {
        __builtin_amdgcn_fence(__ATOMIC_RELEASE, "agent");
        asm volatile("s_waitcnt vmcnt(0)" ::: "memory");
        (void)xb_add(&bar[XB_PB(k)], 1u);
        XB_SPIN(xb_ld(&bar[XB_PB(k)]) < expected, bar);
        __builtin_amdgcn_fence(__ATOMIC_ACQUIRE, "agent");
        asm volatile("s_waitcnt vmcnt(0)" ::: "memory");
    }
    __syncthreads();
}
__device__ __forceinline__ void p5a_stream_select(const Args& a, LAS unsigned char* lds) {
    const int tid = threadIdx.x, lane = tid & 63, wave = __builtin_amdgcn_readfirstlane(tid >> 6), G = gridDim.x, bid = blockIdx.x;
    LAS unsigned* rb = (LAS unsigned*)(lds + LDS_BARW - 16);
    if (tid < 2) rb[tid] = 0u;
    __syncthreads();
    if (wave < 4) {
        const float kbA = wave_max(fabsf(a.in[9][lane])) * 8.0f * 1.01f;
        unsigned ep = 0u;
        for (int task = bid; task < DB * 2; task += G) stream_task(a, task, wave, kbA, rb, ep);
    } else {
        peer_topk(a, lds, 4, 4, 0, NTP);
        sample_mixer_b(a, 4, 4);
    }
    __syncthreads();
}
__global__ void __launch_bounds__(NTHREADS, 2) fwd_kernel(Args args) {
    extern __shared__ __attribute__((aligned(16))) unsigned char lds_raw[];
    LAS unsigned char* lds = (LAS unsigned char*)lds_raw;
    const int tid = threadIdx.x;
    if (tid < 8) ((LAS unsigned*)(lds + LDS_BARW - 16))[tid] = 0u;
    __syncthreads();
    const int lo = args.ph_lo, hi = args.ph_hi;
    const bool one = (hi - lo) > 1;
    XcdBarrier bar; bar.bar = (unsigned*)(args.ws + WS_BAR); bar.x = 0; bar.st = nullptr;
    if (one) bar = xcd_barrier_post((unsigned*)(args.ws + WS_BAR), (volatile LAS unsigned*)(lds + LDS_BARW));
#ifndef PH_MASK
#define PH_MASK 1023
#endif
#define IN(k) (((PH_MASK >> (k)) & 1) && lo <= (k) && (k) < hi)
#define SEAM(k) do { if (IN(k) && IN((k) + 1)) xcd_barrier(bar); } while (0)
    unsigned char* ws = args.ws;
    if (IN(0)) p0_prologue(args, lds);
    SEAM(0);
    if (IN(1)) {
        const int G = (int)gridDim.x, GP = (CONV_IN_P1 && G == 256) ? 208 : G;
        if ((int)blockIdx.x < GP) {
            pg8::Gemm g{(const bf16_t*)(ws + WS_XB), (const bf16_t*)(ws + WS_BT1), MT, NQKV, DM}; pg8::StaticOrder S; S.init(MT, NQKV, GP, (int)blockIdx.x);
            EpiQKV E{(const float*)(ws + WS_RSTD1), args.in[8], args.in[9], args.in[10], args.in[11],
                     (bf16_t*)(ws + WS_QA), (bf16_t*)(ws + WS_KA), (bf16_t*)(ws + WS_VAT), (bf16_t*)(ws + WS_QB), (bf16_t*)(ws + WS_KB), (bf16_t*)(ws + WS_VBT), args.out};
            pg8::gemm_phase<EpiQKV, pg8::StaticOrder, true, true>(lds, g, S, E);
        } else tables_fp8(args, ((int)blockIdx.x - GP) * NWAVES + __builtin_amdgcn_readfirstlane(threadIdx.x >> 6), (G - GP) * NWAVES);
    }
    SEAM(1);
    if (IN(2)) p2_attention(args, lds);
    SEAM(2);
#define GEMM_H(ROW0, MROWS, GG, CC) do { pg8::Gemm g{(const bf16_t*)(ws + WS_CAT) + (size_t)(ROW0) * DM, (const bf16_t*)(ws + WS_BT2), (MROWS), DM, DM}; pg8::StaticOrder S; S.init((MROWS), DM, (GG), (CC)); \
        EpiH E{args.in[0], args.in[1], (float*)(ws + WS_H), (bf16_t*)(ws + WS_HB), (float*)(ws + WS_ROWSS), (ROW0)}; \
        pg8::gemm_phase<EpiH, pg8::StaticOrder, true, true>(lds, g, S, E); } while (0)
#define GEMM_S(ROW0, MROWS, GG, CC) do { pg8::Gemm g{(const bf16_t*)(ws + WS_HB) + (size_t)(ROW0) * DM, (const bf16_t*)(ws + WS_BT3), (MROWS), NPQ, DM}; pg8::StaticOrder S; S.init((MROWS), NPQ, (GG), (CC)); \
        EpiS E{(const float*)(ws + WS_ROWSS), (float*)(ws + WS_S), (ROW0)}; \
        pg8::gemm_phase<EpiS, pg8::StaticOrder, true, true>(lds, g, S, E); } while (0)
    if (IN(3)) GEMM_H(0, NTP, (int)gridDim.x, (int)blockIdx.x);
    SEAM(3);
    if (IN(4)) GEMM_S(0, NTP, (int)gridDim.x, (int)blockIdx.x);
    SEAM(4);
    if (IN(5)) p5a_stream_select(args, lds);
    SEAM(5);
    const int wv = __builtin_amdgcn_readfirstlane(threadIdx.x >> 6), NI = (int)gridDim.x >> 3;
    if (IN(6)) {
        constexpr int ND = 2;
        const int cc = (int)blockIdx.x - 8 * (NI - ND);
        if (cc < 0) peer_passA<false>(args, peer_work_plain(wv, NWAVES, NI - ND, 0, NTP));
        else {
            GEMM_H(NTP, NTS, 8 * ND, cc);
            peer_barrier((unsigned*)(ws + WS_BAR), 2, 8u * ND);
            GEMM_S(NTP, NTS, 8 * ND, cc);
        }
    }
    SEAM(6);
    if (IN(7)) { if (wv < 4) peer_coef(args, (int)blockIdx.x * 4 + wv, (int)gridDim.x * 4, 0, NTP); else peer_topk(args, lds, 4, 4, NTP, MT); }
    SEAM(7);
    if (IN(8)) { peer_passB<false>(args, peer_work_plain(wv, NWAVES, NI, 0, NTP)); peer_passA<false>(args, peer_work_plain(wv, NWAVES, NI, NTP, MT)); }
    SEAM(8);
    if (IN(9)) {
        for (int t = NTP + (int)(blockIdx.x >> 3) + NI * wv; t < MT; t += NI * NWAVES) peer_coef(args, 0, 1, t, t + 1);
        asm volatile("s_waitcnt vmcnt(0)" ::: "memory");
        __syncthreads();
        peer_passB<false>(args, peer_work_plain(wv, NWAVES, NI, NTP, MT));
    }

#undef IN
#undef SEAM
}

extern "C" void kernel_launch(void* const* d_in, const int* in_sizes, int n_in, void* d_out, int out_size, void* d_ws, size_t ws_size, hipStream_t stream) {
    static int grid = 0;
    if (grid == 0) {
        if (n_in != 19 || (size_t)out_size != O_END || ws_size < WS_END) { fprintf(stderr, "kernel_launch: unexpected shapes (n_in %d out %d ws %zu)\n", n_in, out_size, ws_size); grid = -1; return; }
        int dev = 0, cus = 0, per_cu = 0;
        if (hipGetDevice(&dev) != hipSuccess || hipDeviceGetAttribute(&cus, hipDeviceAttributeMultiprocessorCount, dev) != hipSuccess) { grid = -1; return; }
        if (hipFuncSetAttribute((const void*)fwd_kernel, hipFuncAttributeMaxDynamicSharedMemorySize, LDS_BYTES) != hipSuccess) { fprintf(stderr, "kernel_launch: hipFuncSetAttribute failed\n"); grid = -1; return; }
        if (hipOccupancyMaxActiveBlocksPerMultiprocessor(&per_cu, (const void*)fwd_kernel, NTHREADS, LDS_BYTES) != hipSuccess || per_cu < 1) { fprintf(stderr, "kernel_launch: occupancy query says %d\n", per_cu); }
        (void)hipGetLastError();
        if (cus < 32 || (cus & 7)) { fprintf(stderr, "kernel_launch: %d CUs\n", cus); grid = -1; return; }
        grid = cus;
    }
    if (grid < 0) return;
    (void)hipMemsetAsync((char*)d_ws + WS_BAR, 0, WS_ZERO_BYTES, stream);
    Args a{};
    for (int i = 0; i < 19; ++i) a.in[i] = (const float*)d_in[i];
    a.out = (float*)d_out; a.ws = (unsigned char*)d_ws;
#if N_LAUNCHES == 1
    a.ph_lo = 0; a.ph_hi = 10;
    hipLaunchKernelGGL(fwd_kernel, dim3(grid), dim3(NTHREADS), LDS_BYTES, stream, a);
#else
    for (int p = 0; p < 10; ++p) { a.ph_lo = p; a.ph_hi = p + 1; hipLaunchKernelGGL(fwd_kernel, dim3(grid), dim3(NTHREADS), LDS_BYTES, stream, a); }
#endif
}
```
